# Optimizing an MI355X kernel written in HIP

```python
import jax
import jax.numpy as jnp
from jax import lax
import numpy as np

D_MODEL = 1024
BATCH = 8
SEQ = 4096
DEPTH = 4

GRID_W = 64
CTX_LEN = 256
HEAD_DIM = 64
N_Q_HEADS = D_MODEL // HEAD_DIM
N_KV_HEADS = N_Q_HEADS // 4
GROUP = N_Q_HEADS // N_KV_HEADS
QKV_DIM = (N_Q_HEADS + 2 * N_KV_HEADS) * HEAD_DIM
WINDOW = 128
BLOCK_Q = 128
ROPE_THETA = 10000.0
CONV_WIDTH = 3
N_EXPERTS = 32
TOP_K = 4
D_FF = D_MODEL
SWIGLU_ALPHA = 1.702
SWIGLU_LIMIT = 7.0
EXPERT_BLOCK = 128
N_MIXERS = 3
N_WIN_LAYERS = (DEPTH + 2) // N_MIXERS
N_CONV_LAYERS = (DEPTH + 1) // N_MIXERS
N_FULL_LAYERS = DEPTH // N_MIXERS
DEEPNORM_ALPHA = (2.0 * DEPTH) ** 0.25
DEEPNORM_BETA = (8.0 * DEPTH) ** -0.25
LN_EPS = 1e-5
RMS_EPS = 1e-6
NEG_INF = -1e30

kernel_name = 'hybrid_interleaved_dit_moe'


def layer_norm(x, g, b):
    xf = x.astype(jnp.float32)
    mu = jnp.mean(xf, axis=-1, keepdims=True)
    var = jnp.mean(jnp.square(xf - mu), axis=-1, keepdims=True)
    return ((xf - mu) * lax.rsqrt(var + LN_EPS) * g.astype(jnp.float32) + b.astype(jnp.float32)).astype(x.dtype)


def rms_norm(x, g):
    xf = x.astype(jnp.float32)
    y = xf * lax.rsqrt(jnp.mean(jnp.square(xf), axis=-1, keepdims=True) + RMS_EPS)
    return (y * g.astype(jnp.float32)).astype(x.dtype)


def axial_rope_tables(rows):
    row = jnp.repeat(jnp.arange(rows, dtype=jnp.float32), GRID_W)
    col = jnp.tile(jnp.arange(GRID_W, dtype=jnp.float32), rows)
    n_freq = HEAD_DIM // 4
    inv_freq = ROPE_THETA ** (-jnp.arange(n_freq, dtype=jnp.float32) / n_freq)
    ang = jnp.stack([row[:, None] * inv_freq, col[:, None] * inv_freq], axis=1)
    return jnp.cos(ang), jnp.sin(ang)


def apply_rope(x, cos, sin):
    B, L, H, Dh = x.shape
    xr = x.astype(jnp.float32).reshape(B, L, H, 2, 2, Dh // 4)
    x1, x2 = xr[..., 0, :], xr[..., 1, :]
    cs, sn = cos[None, :, None], sin[None, :, None]
    out = jnp.stack([x1 * cs - x2 * sn, x2 * cs + x1 * sn], axis=-2)
    return out.reshape(B, L, H, Dh).astype(x.dtype)


def project_qkv(h, w, b=None):
    B, L, _ = h.shape
    qkv = h @ w
    if b is not None:
        qkv = qkv + b
    q, k, v = jnp.split(qkv, [N_Q_HEADS * HEAD_DIM, (N_Q_HEADS + N_KV_HEADS) * HEAD_DIM], axis=-1)
    return (q.reshape(B, L, N_Q_HEADS, HEAD_DIM),
            k.reshape(B, L, N_KV_HEADS, HEAD_DIM),
            v.reshape(B, L, N_KV_HEADS, HEAD_DIM))


def attend(q, k, v, mask=None, sink=None):
    s = jnp.einsum('bqhgd,bkhd->bhgqk', q, k).astype(jnp.float32) * (HEAD_DIM ** -0.5)
    if mask is not None:
        s = jnp.where(mask, s, NEG_INF)
    if sink is not None:
        B, H, G, Q, _ = s.shape
        s_sink = jnp.broadcast_to(sink.astype(jnp.float32)[None, :, :, None, None], (B, H, G, Q, 1))
        p = jax.nn.softmax(jnp.concatenate([s, s_sink], axis=-1), axis=-1)[..., :-1]
    else:
        p = jax.nn.softmax(s, axis=-1)
    return jnp.einsum('bhgqk,bkhd->bqhgd', p.astype(v.dtype), v)


def window_attention(hx, hz, w_qkv, b_qkv, sink, w_o, cos, sin, need_ctx):
    B, L, _ = hx.shape
    nb = L // BLOCK_Q
    qx, kx, vx = project_qkv(hx, w_qkv, b_qkv)
    qz, kz, vz = project_qkv(hz, w_qkv, b_qkv)
    qx = apply_rope(qx, cos, sin)
    kx = apply_rope(kx, cos, sin)
    sink_hg = sink.reshape(N_KV_HEADS, GROUP)
    ctx_len = kz.shape[1]

    def band(t):
        tp = jnp.pad(t, ((0, 0), (BLOCK_Q, BLOCK_Q), (0, 0), (0, 0))).reshape(B, nb + 2, BLOCK_Q, N_KV_HEADS, HEAD_DIM)
        return jnp.concatenate([tp[:, :-2], tp[:, 1:-1], tp[:, 2:]], axis=2)

    kb, vb = band(kx), band(vx)
    qb = qx.reshape(B, nb, BLOCK_Q, N_KV_HEADS, GROUP, HEAD_DIM)
    qi = jnp.arange(BLOCK_Q)[:, None]
    kj = jnp.arange(3 * BLOCK_Q)[None, :]
    rel = kj - BLOCK_Q - qi
    ctx_mask = jnp.ones((BLOCK_Q, ctx_len), dtype=bool)

    def block_fn(args):
        q, k, v, blk = args
        key_pos = blk * BLOCK_Q - BLOCK_Q + kj
        m_loc = (jnp.abs(rel) <= WINDOW) & (key_pos >= 0) & (key_pos < L)
        k_cat = jnp.concatenate([k, kz], axis=1)
        v_cat = jnp.concatenate([v, vz], axis=1)
        m_cat = jnp.concatenate([m_loc, ctx_mask], axis=1)
        return attend(q, k_cat, v_cat, mask=m_cat, sink=sink_hg)

    ox = lax.map(block_fn, (jnp.moveaxis(qb, 1, 0), jnp.moveaxis(kb, 1, 0), jnp.moveaxis(vb, 1, 0), jnp.arange(nb)))
    out_x = jnp.moveaxis(ox, 0, 1).reshape(B, L, D_MODEL) @ w_o
    out_z = None
    if need_ctx:
        oz = attend(qz.reshape(B, ctx_len, N_KV_HEADS, GROUP, HEAD_DIM), kz, vz, sink=sink_hg)
        out_z = oz.reshape(B, ctx_len, D_MODEL) @ w_o
    return out_x, out_z


def full_attention(hx, hz, w_qkv, q_norm, k_norm, w_o, cos, sin, need_ctx):
    B, L, _ = hx.shape
    nb = L // BLOCK_Q
    qx, kx, vx = project_qkv(hx, w_qkv)
    qz, kz, vz = project_qkv(hz, w_qkv)
    qx = apply_rope(rms_norm(qx, q_norm), cos, sin)
    kx = apply_rope(rms_norm(kx, k_norm), cos, sin)
    qz = rms_norm(qz, q_norm)
    kz = rms_norm(kz, k_norm)
    ctx_len = kz.shape[1]
    k_all = jnp.concatenate([kx, kz], axis=1)
    v_all = jnp.concatenate([vx, vz], axis=1)
    qb = jnp.moveaxis(qx.reshape(B, nb, BLOCK_Q, N_KV_HEADS, GROUP, HEAD_DIM), 1, 0)
    ox = lax.map(lambda q: attend(q, k_all, v_all), qb)
    out_x = jnp.moveaxis(ox, 0, 1).reshape(B, L, D_MODEL) @ w_o
    out_z = None
    if need_ctx:
        oz = attend(qz.reshape(B, ctx_len, N_KV_HEADS, GROUP, HEAD_DIM), kz, vz)
        out_z = oz.reshape(B, ctx_len, D_MODEL) @ w_o
    return out_x, out_z


def depthwise_conv_centred(u, w):
    pad = CONV_WIDTH // 2
    return lax.conv_general_dilated(u, w[:, None, :], window_strides=(1,), padding=((pad, pad),),
                                    dimension_numbers=('NWC', 'WIO', 'NWC'), feature_group_count=u.shape[-1])


def short_conv_mixer(h, w_in, w_conv, w_out):
    b_gate, c_gate, xv = jnp.split(h @ w_in, 3, axis=-1)
    return (b_gate * depthwise_conv_centred(c_gate * xv, w_conv)) @ w_out


def moe_ffn(h, router_w, router_b, w_gu, b_gu, w_down, b_down):
    T, D = h.shape
    logits = (h @ router_w + router_b).astype(jnp.float32)
    top_val, top_idx = lax.top_k(logits, TOP_K)
    gates = jax.nn.softmax(top_val, axis=-1)
    A = T * TOP_K
    e_flat = top_idx.reshape(A)
    tok_flat = jnp.broadcast_to(jnp.arange(T, dtype=jnp.int32)[:, None], (T, TOP_K)).reshape(A)
    g_flat = gates.reshape(A)
    order = jnp.argsort(e_flat)
    e_sorted = e_flat[order]
    counts = jnp.bincount(e_flat, length=N_EXPERTS)
    starts = jnp.cumsum(counts) - counts
    padded = (counts + EXPERT_BLOCK - 1) // EXPERT_BLOCK * EXPERT_BLOCK
    pends = jnp.cumsum(padded)
    pstarts = pends - padded
    dest = pstarts[e_sorted] + (jnp.arange(A) - starts[e_sorted])
    nblk = -(-A // EXPERT_BLOCK) + N_EXPERTS
    P = nblk * EXPERT_BLOCK
    tok_buf = jnp.full((P,), T, dtype=jnp.int32).at[dest].set(tok_flat[order])
    g_buf = jnp.zeros((P,), dtype=h.dtype).at[dest].set(g_flat[order].astype(h.dtype))
    blk_expert = jnp.minimum(jnp.searchsorted(pends, jnp.arange(nblk) * EXPERT_BLOCK, side='right'), N_EXPERTS - 1)
    h_pad = jnp.concatenate([h, jnp.zeros((1, D), h.dtype)], axis=0)

    def expert_block(args):
        toks, e = args
        xb = h_pad[toks]
        gate, up = jnp.split(xb @ w_gu[e] + b_gu[e], 2, axis=-1)
        gate = jnp.minimum(gate, SWIGLU_LIMIT)
        up = jnp.clip(up, -SWIGLU_LIMIT, SWIGLU_LIMIT)
        act = (up + 1) * gate * jax.nn.sigmoid(SWIGLU_ALPHA * gate)
        return act @ w_down[e] + b_down[e]

    out = lax.map(expert_block, (tok_buf.reshape(nblk, EXPERT_BLOCK), blk_expert)).reshape(P, D)
    y = jnp.zeros((T + 1, D), dtype=h.dtype).at[tok_buf].add(out * g_buf[:, None])
    return y[:T]


def setup_inputs(seed: int = 0) -> dict:
    key = jax.random.key(seed)
    ks = iter(jax.random.split(key, 32))
    D = D_MODEL
    s = D ** -0.5

    def nrm(shape, std):
        return std * jax.random.normal(next(ks), shape, jnp.float32)

    return {
        'x': nrm((BATCH, SEQ, D), 1.0),
        'c': nrm((BATCH, D), 1.0),
        'ctx': nrm((BATCH, CTX_LEN, D), 1.0),
        'c_ctx': nrm((D,), 1.0),
        'mod_w': nrm((DEPTH, D, 6 * D), s),
        'mod_b': nrm((DEPTH, 6 * D), 0.01),
        'ln1_g': 1.0 + nrm((DEPTH, D), 0.01),
        'ln1_b': nrm((DEPTH, D), 0.01),
        'ln2_g': 1.0 + nrm((DEPTH, D), 0.01),
        'ln2_b': nrm((DEPTH, D), 0.01),
        'win_wqkv': nrm((N_WIN_LAYERS, D, QKV_DIM), s),
        'win_bqkv': nrm((N_WIN_LAYERS, QKV_DIM), 0.01),
        'win_sink': nrm((N_WIN_LAYERS, N_Q_HEADS), 0.5),
        'win_wo': nrm((N_WIN_LAYERS, D, D), s * DEEPNORM_BETA),
        'conv_win': nrm((N_CONV_LAYERS, D, 3 * D), s),
        'conv_w': nrm((N_CONV_LAYERS, CONV_WIDTH, D), CONV_WIDTH ** -0.5),
        'conv_wout': nrm((N_CONV_LAYERS, D, D), s * DEEPNORM_BETA),
        'full_wqkv': nrm((N_FULL_LAYERS, D, QKV_DIM), s),
        'full_qnorm': 1.0 + nrm((N_FULL_LAYERS, HEAD_DIM), 0.01),
        'full_knorm': 1.0 + nrm((N_FULL_LAYERS, HEAD_DIM), 0.01),
        'full_wo': nrm((N_FULL_LAYERS, D, D), s * DEEPNORM_BETA),
        'router_w': nrm((DEPTH, D, N_EXPERTS), s),
        'router_b': nrm((DEPTH, N_EXPERTS), 0.01),
        'expert_wgu': nrm((DEPTH, N_EXPERTS, D, 2 * D_FF), s),
        'expert_bgu': nrm((DEPTH, N_EXPERTS, 2 * D_FF), 0.01),
        'expert_wdown': nrm((DEPTH, N_EXPERTS, D_FF, D), D_FF ** -0.5 * DEEPNORM_BETA),
        'expert_bdown': nrm((DEPTH, N_EXPERTS, D), 0.01),
    }


def reference(x, c, ctx, c_ctx, mod_w, mod_b, ln1_g, ln1_b, ln2_g, ln2_b,
              win_wqkv, win_bqkv, win_sink, win_wo, conv_win, conv_w, conv_wout,
              full_wqkv, full_qnorm, full_knorm, full_wo,
              router_w, router_b, expert_wgu, expert_bgu, expert_wdown, expert_bdown):
    B, L, D = x.shape
    ROWS = L // GRID_W
    cos, sin = axial_rope_tables(ROWS)
    silu_c = jax.nn.silu(c)
    silu_cz = jax.nn.silu(c_ctx)
    z = ctx
    for i in range(DEPTH):
        kind, j = i % N_MIXERS, i // N_MIXERS
        need_ctx = i < DEPTH - 1
        mx = (silu_c @ mod_w[i] + mod_b[i])[:, None, :]
        sh1, sc1, g1, sh2, sc2, g2 = jnp.split(mx, 6, axis=-1)
        mz = silu_cz @ mod_w[i] + mod_b[i]
        zsh1, zsc1, zg1, zsh2, zsc2, zg2 = jnp.split(mz, 6, axis=-1)

        hx = x * (1 + sc1) + sh1
        hz = z * (1 + zsc1) + zsh1
        if kind == 0:
            ox, oz = window_attention(hx, hz, win_wqkv[j], win_bqkv[j], win_sink[j], win_wo[j], cos, sin, need_ctx)
        elif kind == 1:
            ox = short_conv_mixer(hx, conv_win[j], conv_w[j], conv_wout[j])
            oz = short_conv_mixer(hz, conv_win[j], conv_w[j], conv_wout[j]) if need_ctx else None
        else:
            ox, oz = full_attention(hx, hz, full_wqkv[j], full_qnorm[j], full_knorm[j], full_wo[j], cos, sin, need_ctx)
        x = layer_norm(DEEPNORM_ALPHA * x + g1 * ox, ln1_g[i], ln1_b[i])

        hx = x * (1 + sc2) + sh2
        moe_args = (router_w[i], router_b[i], expert_wgu[i], expert_bgu[i], expert_wdown[i], expert_bdown[i])
        if need_ctx:
            z = layer_norm(DEEPNORM_ALPHA * z + zg1 * oz, ln1_g[i], ln1_b[i])
            hz = z * (1 + zsc2) + zsh2
            ctx_len = z.shape[1]
            tokens = jnp.concatenate([hx.reshape(B * L, D), hz.reshape(B * ctx_len, D)], axis=0)
            f = moe_ffn(tokens, *moe_args)
            fx = f[:B * L].reshape(B, L, D)
            fz = f[B * L:].reshape(B, ctx_len, D)
            z = layer_norm(DEEPNORM_ALPHA * z + zg2 * fz, ln2_g[i], ln2_b[i])
        else:
            fx = moe_ffn(hx.reshape(B * L, D), *moe_args).reshape(B, L, D)
        x = layer_norm(DEEPNORM_ALPHA * x + g2 * fx, ln2_g[i], ln2_b[i])
    return x
```

```cpp
#include <hip/hip_runtime.h>
#include <cstdio>
#include <cstdint>

#define LAS __attribute__((address_space(3)))
typedef unsigned short bf16;
typedef short bf16x8 __attribute__((ext_vector_type(8)));
typedef float f32x4 __attribute__((ext_vector_type(4)));
typedef float f32x2 __attribute__((ext_vector_type(2)));
typedef unsigned u32x4 __attribute__((ext_vector_type(4)));
typedef unsigned u32x2 __attribute__((ext_vector_type(2)));

constexpr int D = 1024, NB = 8, SEQ = 4096, CL = 256, ML = NB * SEQ, MZ = NB * CL, M = ML + MZ, DEPTH = 4;
constexpr int NE = 32, TOPK = 4, DFF = 1024, QKVD = 1536;
constexpr int CAP = M;
constexpr int TM = 128;
constexpr int PMAX = 147456;
constexpr float DN_ALPHA = 1.681792830507429f;
constexpr float LN_EPS = 1e-5f, RMS_EPS = 1e-6f;

constexpr size_t MiB = 1u << 20;
constexpr size_t WS_CTL = 0, CTL_BYTES = 1 * MiB;
constexpr size_t WS_MOD = 1 * MiB;
constexpr size_t WS_ROPE = 2 * MiB;
constexpr size_t WS_ASG = 3 * MiB;
constexpr size_t WS_GATE = 4 * MiB;
constexpr size_t WS_TOKL = 5 * MiB;
constexpr size_t WS_X = 16 * MiB;
constexpr size_t WS_H = WS_X + 136 * MiB;
constexpr size_t WS_BIG = WS_H + 68 * MiB;
constexpr size_t WS_O = WS_BIG + 204 * MiB;
constexpr size_t WS_MX = WS_O + 68 * MiB;
constexpr size_t WS_ACT = WS_MX + 68 * MiB;
constexpr size_t WS_OUTE = WS_ACT + 288 * MiB;
constexpr size_t WS_END = WS_OUTE + 288 * MiB;
constexpr int CW_CNT = 64;

__device__ __forceinline__ float bf2f(unsigned v) { return __uint_as_float(v << 16); }
__device__ __forceinline__ unsigned f2bf(float f) { unsigned u = __float_as_uint(f); return (u + 0x7fffu + ((u >> 16) & 1u)) >> 16; }
__device__ __forceinline__ unsigned pk2(float lo, float hi) { return f2bf(lo) | (f2bf(hi) << 16); }
__device__ __forceinline__ float wave_sum(float v) {
#pragma unroll
    for (int o = 1; o < 64; o <<= 1) v += __shfl_xor(v, o);
    return v;
}
__device__ __forceinline__ int mod_row(int row) { return row < ML ? (row >> 12) : 8; }
__device__ __forceinline__ f32x4 bf4(u32x2 w) { return (f32x4){bf2f(w.x & 0xffffu), bf2f(w.x >> 16), bf2f(w.y & 0xffffu), bf2f(w.y >> 16)}; }
__device__ __forceinline__ u32x2 pk4(f32x4 v) { u32x2 w; w.x = pk2(v.x, v.y); w.y = pk2(v.z, v.w); return w; }

struct Ptrs {
    const float* in[27];
    float* out;
    unsigned char* ws;
};
#define P_X(p) ((float*)((p).ws + WS_X))
#define P_H(p) ((bf16*)((p).ws + WS_H))
#define P_BIG(p) ((bf16*)((p).ws + WS_BIG))
#define P_O(p) ((bf16*)((p).ws + WS_O))
#define P_MX(p) ((bf16*)((p).ws + WS_MX))
#define P_ACT(p) ((bf16*)((p).ws + WS_ACT))
#define P_OUTE(p) ((bf16*)((p).ws + WS_OUTE))
#define P_MOD(p) ((float*)((p).ws + WS_MOD))
#define P_ROPE(p) ((f32x2*)((p).ws + WS_ROPE))
#define P_ASG(p) ((int*)((p).ws + WS_ASG))
#define P_GATE(p) ((float*)((p).ws + WS_GATE))
#define P_TOKL(p) ((int*)((p).ws + WS_TOKL))
#define P_CTL(p) ((unsigned*)((p).ws + WS_CTL))

__global__ __launch_bounds__(256) void k_mod(Ptrs p) {
    __shared__ float s[9][1024];
    const int l = blockIdx.y, n = blockIdx.x * 256 + threadIdx.x;
    for (int i = threadIdx.x; i < 9 * 1024; i += 256) { const int r = i >> 10, k = i & 1023; const float v = r < 8 ? p.in[1][r * 1024 + k] : p.in[3][k]; s[r][k] = v / (1.f + __expf(-v)); }
    __syncthreads();
    float acc[9];
#pragma unroll
    for (int r = 0; r < 9; ++r) acc[r] = 0.f;
    const float* w = p.in[4] + (size_t)l * 1024 * 6144 + n;
    for (int k = 0; k < 1024; ++k) { const float wv = w[(size_t)k * 6144];
#pragma unroll
        for (int r = 0; r < 9; ++r) acc[r] += s[r][k] * wv; }
    const float bv = p.in[5][l * 6144 + n];
#pragma unroll
    for (int r = 0; r < 9; ++r) P_MOD(p)[((size_t)l * 9 + r) * 6144 + n] = acc[r] + bv;
    if (blockIdx.x == 0 && blockIdx.y == 0) {
        for (int i = threadIdx.x; i < 64 * 16; i += 256) { const int pos = i >> 4, f = i & 15; const float inv = exp2f(-(float)f * (1.f / 16.f) * 13.287712379549449f); const float a = (float)pos * inv;
            P_ROPE(p)[i] = (f32x2){cosf(a), sinf(a)}; }
    }
}

#define ROW_LOOP(nrows) const int lane = threadIdx.x & 63, wave = threadIdx.x >> 6, nwv = blockDim.x >> 6; for (int row = blockIdx.x * nwv + wave; row < (nrows); row += gridDim.x * nwv)

__device__ __forceinline__ void ph_input(const Ptrs& p) {
    ROW_LOOP(M) {
        const f32x4* src = (const f32x4*)(row < ML ? p.in[0] + (size_t)row * D : p.in[2] + (size_t)(row - ML) * D) + lane;
        const f32x4* md = (const f32x4*)(P_MOD(p) + (size_t)mod_row(row) * 6144) + lane;
        f32x4* xo = (f32x4*)(P_X(p) + (size_t)row * D) + lane; u32x2* ho = (u32x2*)(P_H(p) + (size_t)row * D) + lane;
#pragma unroll
        for (int j = 0; j < 4; ++j) { const f32x4 v = src[64 * j], sh = md[64 * j], sc = md[256 + 64 * j]; xo[64 * j] = v; ho[64 * j] = pk4(v * (1.f + sc) + sh); }
    }
}
__global__ __launch_bounds__(512) void k_input(Ptrs p) { ph_input(p); }

template <int KIND> __device__ __forceinline__ void ph_qk(const Ptrs& p, const float* qn, const float* kn) {
    ROW_LOOP(M) {
        bf16* r = P_BIG(p) + (size_t)row * QKVD;
        const int t = row & 4095, axis = lane >> 5, half = (lane >> 4) & 1, f = lane & 15, pos = axis ? (t & 63) : (t >> 6);
        const f32x2 cs = P_ROPE(p)[pos * 16 + f];
        const float gq = KIND == 2 ? qn[lane] : 1.f, gk = KIND == 2 ? kn[lane] : 1.f;
        for (int hh = 0; hh < 20; ++hh) {
            float v = bf2f(r[hh * 64 + lane]);
            if (KIND == 2) { const float ss = wave_sum(v * v); v = v * (1.0f / sqrtf(ss * (1.f / 64.f) + RMS_EPS)) * (hh < 16 ? gq : gk); }
            if (row < ML) { const float o = __shfl_xor(v, 16); v = half == 0 ? v * cs.x - o * cs.y : v * cs.x + o * cs.y; }
            if (hh < 16) v *= 0.125f;
            r[hh * 64 + lane] = (bf16)f2bf(v);
        }
    }
}
template <int KIND> __global__ __launch_bounds__(512) void k_qk(Ptrs p, const float* qn, const float* kn) { ph_qk<KIND>(p, qn, kn); }

__device__ __forceinline__ void ph_conv(const Ptrs& p, const float* cw, int nrows) {
    ROW_LOOP(nrows) {
        const int t = row < ML ? (row & 4095) : ((row - ML) & 255), tl = row < ML ? 4095 : 255;
        const bool vp = t != 0, vn = t != tl;
        const u32x2* u = (const u32x2*)(P_BIG(p) + (size_t)row * 3072) + lane;
        u32x2* yo = (u32x2*)(P_O(p) + (size_t)row * D) + lane;
#pragma unroll
        for (int j = 0; j < 4; ++j) {
            const f32x4 bg = bf4(u[64 * j]), c0 = bf4(u[256 + 64 * j]) * bf4(u[512 + 64 * j]);
            f32x4 cp = (f32x4){0.f, 0.f, 0.f, 0.f}, cn = cp;
            if (vp) cp = bf4((u - 768)[256 + 64 * j]) * bf4((u - 768)[512 + 64 * j]);
            if (vn) cn = bf4((u + 768)[256 + 64 * j]) * bf4((u + 768)[512 + 64 * j]);
            const f32x4 w0 = ((const f32x4*)cw + lane)[64 * j], w1 = ((const f32x4*)(cw + 1024) + lane)[64 * j], w2 = ((const f32x4*)(cw + 2048) + lane)[64 * j];
            yo[64 * j] = pk4(bg * (w0 * cp + w1 * c0 + w2 * cn));
        }
    }
}
__global__ __launch_bounds__(512) void k_conv(Ptrs p, const float* cw, int nrows) { ph_conv(p, cw, nrows); }

constexpr int MAXR = 160;
__device__ __forceinline__ void ph_ln1(const Ptrs& p, int layer, int nrows, LAS int* lcnt  , LAS int* lbase  , LAS int* lasg  ) {
    const float* g = p.in[6] + layer * D; const float* bb = p.in[7] + layer * D;
    const float* rw = p.in[21] + (size_t)layer * D * NE; const float* rb = p.in[22] + layer * NE;
    unsigned* cnt = P_CTL(p) + CW_CNT + layer * 64;
    if (threadIdx.x < 32) lcnt[threadIdx.x] = 0;
    __syncthreads();
    int it = 0;
    {
    ROW_LOOP(nrows) {
        const f32x4* md = (const f32x4*)(P_MOD(p) + ((size_t)layer * 9 + mod_row(row)) * 6144) + lane;
        f32x4* xr = (f32x4*)(P_X(p) + (size_t)row * D) + lane;
        const u32x2* mx = (const u32x2*)(P_MX(p) + (size_t)row * D) + lane;
        f32x4 v[4]; float s = 0.f;
#pragma unroll
        for (int j = 0; j < 4; ++j) { v[j] = xr[64 * j] * DN_ALPHA + md[512 + 64 * j] * bf4(mx[64 * j]); s += (v[j].x + v[j].y) + (v[j].z + v[j].w); }
        const float mean = wave_sum(s) * (1.f / D); float s2 = 0.f;
#pragma unroll
        for (int j = 0; j < 4; ++j) { v[j] = v[j] - mean; s2 += (v[j].x * v[j].x + v[j].y * v[j].y) + (v[j].z * v[j].z + v[j].w * v[j].w); }
        const float rstd = 1.f / sqrtf(wave_sum(s2) * (1.f / D) + LN_EPS);
        u32x2* ho = (u32x2*)(P_H(p) + (size_t)row * D) + lane;
        float logit[32];
#pragma unroll
        for (int e = 0; e < 32; ++e) logit[e] = 0.f;
#pragma unroll
        for (int j = 0; j < 4; ++j) {
            const f32x4 xn = v[j] * rstd * ((const f32x4*)g + lane)[64 * j] + ((const f32x4*)bb + lane)[64 * j];
            xr[64 * j] = xn;
            const f32x4 h = xn * (1.f + md[1024 + 64 * j]) + md[768 + 64 * j];
            ho[64 * j] = pk4(h);
#pragma unroll
            for (int i = 0; i < 4; ++i) { const f32x4* rwk = (const f32x4*)(rw + (size_t)(4 * (lane + 64 * j) + i) * NE); const float hv = h[i];
#pragma unroll
                for (int q = 0; q < 8; ++q) { const f32x4 w = rwk[q]; logit[4 * q] += hv * w.x; logit[4 * q + 1] += hv * w.y; logit[4 * q + 2] += hv * w.z; logit[4 * q + 3] += hv * w.w; } }
        }
#pragma unroll
        for (int e = 0; e < 32; ++e) logit[e] = wave_sum(logit[e]) + rb[e];
        int idx[4]; float val[4]; unsigned taken = 0u;
#pragma unroll
        for (int k = 0; k < 4; ++k) { float best = -3.0e38f; int bi = 0;
#pragma unroll
            for (int e = 0; e < 32; ++e) { const bool c = !((taken >> e) & 1u) && logit[e] > best; best = c ? logit[e] : best; bi = c ? e : bi; }
            taken |= 1u << bi; idx[k] = bi; val[k] = best; }
        float pe[4], ps = 0.f;
#pragma unroll
        for (int k = 0; k < 4; ++k) { pe[k] = __expf(val[k] - val[0]); ps += pe[k]; }
        if (lane == 0) {
#pragma unroll
            for (int k = 0; k < 4; ++k) { const int lr = atomicAdd((int*)&lcnt[idx[k]], 1); lasg[(it * nwv + wave) * 4 + k] = idx[k] | (lr << 8); P_GATE(p)[(size_t)row * 4 + k] = pe[k] / ps; }
        }
        ++it;
    }
    }
    __syncthreads();
    if (threadIdx.x < 32) lbase[threadIdx.x] = (int)__hip_atomic_fetch_add(cnt + threadIdx.x, (unsigned)lcnt[threadIdx.x], __ATOMIC_RELAXED, __HIP_MEMORY_SCOPE_AGENT);
    __syncthreads();
    it = 0;
    {
    ROW_LOOP(nrows) {
        if (lane < 4) { const int a = lasg[(it * nwv + wave) * 4 + lane]; const int e = a & 255, rk = lbase[e] + (a >> 8);
            P_ASG(p)[(size_t)row * 4 + lane] = e | (rk << 8); P_TOKL(p)[(size_t)e * CAP + rk] = row; }
        ++it;
    }
    }
}
__global__ __launch_bounds__(512) void k_ln1(Ptrs p, int layer, int nrows) {
    __shared__ int lcnt[32], lbase[32], lasg[MAXR * 4];
    ph_ln1(p, layer, nrows, (LAS int*)lcnt, (LAS int*)lbase, (LAS int*)lasg);
}

__device__ __forceinline__ void ph_ln2(const Ptrs& p, int layer, int nrows, LAS int* pst  ) {
    const float* g = p.in[8] + layer * D; const float* bb = p.in[9] + layer * D;
    const unsigned* cnt = P_CTL(p) + CW_CNT + layer * 64;
    if (threadIdx.x == 0) { int a = 0; for (int e = 0; e < 32; ++e) { pst[e] = a; a += ((int)__hip_atomic_load(cnt + e, __ATOMIC_RELAXED, __HIP_MEMORY_SCOPE_AGENT) + TM - 1) / TM * TM; } }
    __syncthreads();
    const bool last = layer == DEPTH - 1;
    ROW_LOOP(nrows) {
        const int mr = mod_row(row);
        const f32x4* md = (const f32x4*)(P_MOD(p) + ((size_t)layer * 9 + mr) * 6144) + lane;
        f32x4* xr = (f32x4*)(P_X(p) + (size_t)row * D) + lane;
        f32x4 f[4];
#pragma unroll
        for (int j = 0; j < 4; ++j) f[j] = (f32x4){0.f, 0.f, 0.f, 0.f};
#pragma unroll
        for (int k = 0; k < 4; ++k) { const int a = P_ASG(p)[(size_t)row * 4 + k]; const float gt = P_GATE(p)[(size_t)row * 4 + k]; const int pos = pst[a & 255] + (a >> 8);
            const u32x2* o = (const u32x2*)(P_OUTE(p) + (size_t)pos * D) + lane;
#pragma unroll
            for (int j = 0; j < 4; ++j) f[j] += bf4(o[64 * j]) * gt; }
        f32x4 v[4]; float s = 0.f;
#pragma unroll
        for (int j = 0; j < 4; ++j) { v[j] = xr[64 * j] * DN_ALPHA + md[1280 + 64 * j] * f[j]; s += (v[j].x + v[j].y) + (v[j].z + v[j].w); }
        const float mean = wave_sum(s) * (1.f / D); float s2 = 0.f;
#pragma unroll
        for (int j = 0; j < 4; ++j) { v[j] = v[j] - mean; s2 += (v[j].x * v[j].x + v[j].y * v[j].y) + (v[j].z * v[j].z + v[j].w * v[j].w); }
        const float rstd = 1.f / sqrtf(wave_sum(s2) * (1.f / D) + LN_EPS);
        if (last) {
            f32x4* oo = (f32x4*)(p.out + (size_t)row * D) + lane;
#pragma unroll
            for (int j = 0; j < 4; ++j) oo[64 * j] = v[j] * rstd * ((const f32x4*)g + lane)[64 * j] + ((const f32x4*)bb + lane)[64 * j];
        } else {
            const f32x4* mdn = (const f32x4*)(P_MOD(p) + ((size_t)(layer + 1) * 9 + mr) * 6144) + lane;
            u32x2* ho = (u32x2*)(P_H(p) + (size_t)row * D) + lane;
#pragma unroll
            for (int j = 0; j < 4; ++j) { const f32x4 xn = v[j] * rstd * ((const f32x4*)g + lane)[64 * j] + ((const f32x4*)bb + lane)[64 * j]; xr[64 * j] = xn; ho[64 * j] = pk4(xn * (1.f + mdn[256 + 64 * j]) + mdn[64 * j]); }
        }
    }
}
__global__ __launch_bounds__(512) void k_ln2(Ptrs p, int layer, int nrows) { __shared__ int pst[32]; ph_ln2(p, layer, nrows, (LAS int*)pst); }

template <class ARow, class WCol>
__device__ __forceinline__ void gemm_core(f32x4 (&acc)[4][4], const bf16* A, int K, ARow arow, const float* W, int ldw, WCol wcol, LAS unsigned char* sA, LAS unsigned char* sB) {
    const int tid = threadIdx.x, wid = tid >> 6, lane = tid & 63, wr = wid >> 1, wc = wid & 1, fr = lane & 15, fq = lane >> 4;
    const bf16* ap[2]; unsigned adst[2]; const float* bp[2]; unsigned bdst[2];
#pragma unroll
    for (int i = 0; i < 2; ++i) { const int q = tid + i * 256, r = q >> 2, c = q & 3; ap[i] = A + (size_t)arow(r) * K + c * 8; adst[i] = r * 64 + c * 16;
        const int k2 = q >> 5, n4 = q & 31; bp[i] = W + (size_t)(2 * k2) * ldw + wcol(n4 * 4); bdst[i] = (n4 * 4) * 64 + (2 * k2) * 2; }
#pragma unroll
    for (int m = 0; m < 4; ++m)
#pragma unroll
        for (int n = 0; n < 4; ++n) acc[m][n] = (f32x4){0.f, 0.f, 0.f, 0.f};
    for (int kt = 0; kt < K / 32; ++kt) {
        u32x4 av[2]; f32x4 b0[2], b1[2];
#pragma unroll
        for (int i = 0; i < 2; ++i) { av[i] = *(const u32x4*)(ap[i] + kt * 32); b0[i] = *(const f32x4*)(bp[i] + (size_t)kt * 32 * ldw); b1[i] = *(const f32x4*)(bp[i] + (size_t)kt * 32 * ldw + ldw); }
        __syncthreads();
#pragma unroll
        for (int i = 0; i < 2; ++i) { *(LAS u32x4*)(sA + adst[i]) = av[i];
#pragma unroll
            for (int j = 0; j < 4; ++j) *(LAS unsigned*)(sB + bdst[i] + j * 64) = pk2(b0[i][j], b1[i][j]); }
        __syncthreads();
        bf16x8 At[4], Bt[4];
#pragma unroll
        for (int m = 0; m < 4; ++m) At[m] = *(const LAS bf16x8*)(sA + (wr * 64 + m * 16 + fr) * 64 + fq * 16);
#pragma unroll
        for (int n = 0; n < 4; ++n) Bt[n] = *(const LAS bf16x8*)(sB + (wc * 64 + n * 16 + fr) * 64 + fq * 16);
#pragma unroll
        for (int m = 0; m < 4; ++m)
#pragma unroll
            for (int n = 0; n < 4; ++n) acc[m][n] = __builtin_amdgcn_mfma_f32_16x16x32_bf16(At[m], Bt[n], acc[m][n], 0, 0, 0);
    }
}

__global__ __launch_bounds__(256) void k_gemm_dense(const bf16* A, const float* W, const float* bias, bf16* O, int N, int K) {
    __shared__ __attribute__((aligned(16))) unsigned char sm[16384];
    const int m0 = blockIdx.y * 128, n0 = blockIdx.x * 128;
    f32x4 acc[4][4];
    gemm_core(acc, A, K, [=](int r) { return m0 + r; }, W, N, [=](int s) { return n0 + s; }, (LAS unsigned char*)sm, (LAS unsigned char*)sm + 8192);
    const int tid = threadIdx.x, wid = tid >> 6, lane = tid & 63, wr = wid >> 1, wc = wid & 1, fr = lane & 15, fq = lane >> 4;
#pragma unroll
    for (int m = 0; m < 4; ++m)
#pragma unroll
        for (int n = 0; n < 4; ++n) { const int col = n0 + wc * 64 + n * 16 + fr; const float bv = bias ? bias[col] : 0.f;
#pragma unroll
            for (int j = 0; j < 4; ++j) { const int row = m0 + wr * 64 + m * 16 + fq * 4 + j; O[(size_t)row * N + col] = (bf16)f2bf(acc[m][n][j] + bv); } }
}

__device__ __forceinline__ bool moe_tile(const unsigned* cnt, int t, int& e, int& tt, int& pbase, int& ce) {
    int pb = 0;
    for (int x = 0; x < 32; ++x) { const int c = (int)cnt[x]; const int nt = (c + TM - 1) / TM; if (t < nt) { e = x; tt = t; pbase = pb; ce = c; return true; } t -= nt; pb += nt * TM; }
    return false;
}
__global__ __launch_bounds__(256) void k_moe_up(Ptrs p, int layer) {
    __shared__ __attribute__((aligned(16))) unsigned char sm[16384];
    const unsigned* cnt = P_CTL(p) + CW_CNT + layer * 64;
    int e, tt, pbase, ce; if (!moe_tile(cnt, blockIdx.y, e, tt, pbase, ce)) return;
    const int* tl = P_TOKL(p) + (size_t)e * CAP; const int f0 = blockIdx.x * 64;
    const float* W = p.in[23] + ((size_t)layer * NE + e) * D * 2 * DFF; const float* bg = p.in[24] + ((size_t)layer * NE + e) * 2 * DFF;
    f32x4 acc[4][4];
    gemm_core(acc, P_H(p), D, [=](int r) { const int i = tt * TM + r; return i < ce ? tl[i] : 0; }, W, 2 * DFF,
              [=](int s) { const int wc_ = s >> 6, n = (s >> 4) & 3, fr_ = s & 15; return f0 + wc_ * 32 + (n >> 1) * 16 + fr_ + (n & 1) * DFF; }, (LAS unsigned char*)sm, (LAS unsigned char*)sm + 8192);
    const int tid = threadIdx.x, wid = tid >> 6, lane = tid & 63, wr = wid >> 1, wc = wid & 1, fr = lane & 15, fq = lane >> 4;
    bf16* act = P_ACT(p);
#pragma unroll
    for (int m = 0; m < 4; ++m)
#pragma unroll
        for (int q = 0; q < 2; ++q) { const int ff = f0 + wc * 32 + q * 16 + fr; const float b_g = bg[ff], b_u = bg[DFF + ff];
#pragma unroll
            for (int j = 0; j < 4; ++j) { const int row = wr * 64 + m * 16 + fq * 4 + j;
                float gt = fminf(acc[m][2 * q][j] + b_g, 7.f), up = fminf(fmaxf(acc[m][2 * q + 1][j] + b_u, -7.f), 7.f);
                const float a = (up + 1.f) * gt / (1.f + __expf(-1.702f * gt));
                act[(size_t)(pbase + tt * TM + row) * DFF + ff] = (bf16)f2bf(a); } }
}
__global__ __launch_bounds__(256) void k_moe_down(Ptrs p, int layer) {
    __shared__ __attribute__((aligned(16))) unsigned char sm[16384];
    const unsigned* cnt = P_CTL(p) + CW_CNT + layer * 64;
    int e, tt, pbase, ce; if (!moe_tile(cnt, blockIdx.y, e, tt, pbase, ce)) return;
    const int n0 = blockIdx.x * 128, r0 = pbase + tt * TM;
    const float* W = p.in[25] + ((size_t)layer * NE + e) * DFF * D; const float* bd = p.in[26] + ((size_t)layer * NE + e) * D;
    f32x4 acc[4][4];
    gemm_core(acc, P_ACT(p), DFF, [=](int r) { return r0 + r; }, W, D, [=](int s) { return n0 + s; }, (LAS unsigned char*)sm, (LAS unsigned char*)sm + 8192);
    const int tid = threadIdx.x, wid = tid >> 6, lane = tid & 63, wr = wid >> 1, wc = wid & 1, fr = lane & 15, fq = lane >> 4;
    bf16* oe = P_OUTE(p);
#pragma unroll
    for (int m = 0; m < 4; ++m)
#pragma unroll
        for (int n = 0; n < 4; ++n) { const int col = n0 + wc * 64 + n * 16 + fr; const float bv = bd[col];
#pragma unroll
            for (int j = 0; j < 4; ++j) { const int row = r0 + wr * 64 + m * 16 + fq * 4 + j; oe[(size_t)row * D + col] = (bf16)f2bf(acc[m][n][j] + bv); } }
}

template <int KIND> __global__ __launch_bounds__(256) void k_attn_naive(Ptrs p, const float* sink) {
    __shared__ f32x4 Ks[64 * 16], Vs[64 * 16];
    const int qb = blockIdx.x, h = blockIdx.y, b = blockIdx.z, hkv = h >> 2, tid = threadIdx.x;
    const bool isz = qb == 16;
    const int qrow = isz ? ML + b * CL + tid : b * SEQ + qb * 256 + tid, pq = qb * 256 + tid;
    const bf16* qkv = P_BIG(p);
    float q[64], o[64];
    { const u32x4* qp = (const u32x4*)(qkv + (size_t)qrow * QKVD + h * 64);
#pragma unroll
      for (int c = 0; c < 8; ++c) { const u32x4 w = qp[c]; q[8 * c] = bf2f(w.x & 0xffffu); q[8 * c + 1] = bf2f(w.x >> 16); q[8 * c + 2] = bf2f(w.y & 0xffffu); q[8 * c + 3] = bf2f(w.y >> 16);
          q[8 * c + 4] = bf2f(w.z & 0xffffu); q[8 * c + 5] = bf2f(w.z >> 16); q[8 * c + 6] = bf2f(w.w & 0xffffu); q[8 * c + 7] = bf2f(w.w >> 16); } }
#pragma unroll
    for (int d = 0; d < 64; ++d) o[d] = 0.f;
    float mx = -1e30f, l = 0.f;
    int ka0 = 0, ka1 = 0;
    if (!isz) { if (KIND == 0) { ka0 = qb * 256 - 128; if (ka0 < 0) ka0 = 0; ka1 = qb * 256 + 384; if (ka1 > SEQ) ka1 = SEQ; } else { ka0 = 0; ka1 = SEQ; } }
    const int nA = (ka1 - ka0) >> 6, nT = nA + 4;
    for (int ti = 0; ti < nT; ++ti) {
        const bool loc = ti < nA; const int kp0 = ka0 + ti * 64; const int krow0 = loc ? b * SEQ + kp0 : ML + b * CL + (ti - nA) * 64;
        __syncthreads();
        { const int key = tid >> 2, ch = tid & 3; const bf16* kr = qkv + (size_t)(krow0 + key) * QKVD + 1024 + hkv * 64 + ch * 16;
#pragma unroll
          for (int c = 0; c < 2; ++c) { const u32x4 kw = ((const u32x4*)kr)[c], vw = ((const u32x4*)(kr + 256))[c];
              Ks[key * 16 + ch * 4 + c * 2] = (f32x4){bf2f(kw.x & 0xffffu), bf2f(kw.x >> 16), bf2f(kw.y & 0xffffu), bf2f(kw.y >> 16)};
              Ks[key * 16 + ch * 4 + c * 2 + 1] = (f32x4){bf2f(kw.z & 0xffffu), bf2f(kw.z >> 16), bf2f(kw.w & 0xffffu), bf2f(kw.w >> 16)};
              Vs[key * 16 + ch * 4 + c * 2] = (f32x4){bf2f(vw.x & 0xffffu), bf2f(vw.x >> 16), bf2f(vw.y & 0xffffu), bf2f(vw.y >> 16)};
              Vs[key * 16 + ch * 4 + c * 2 + 1] = (f32x4){bf2f(vw.z & 0xffffu), bf2f(vw.z >> 16), bf2f(vw.w & 0xffffu), bf2f(vw.w >> 16)}; } }
        __syncthreads();
        for (int j = 0; j < 64; ++j) {
            if (KIND == 0 && loc) { const int dd = kp0 + j - pq; if (dd > 128 || dd < -128) continue; }
            float s = 0.f;
#pragma unroll
            for (int c = 0; c < 16; ++c) { const f32x4 kk = Ks[j * 16 + c]; s += q[4 * c] * kk.x + q[4 * c + 1] * kk.y + q[4 * c + 2] * kk.z + q[4 * c + 3] * kk.w; }
            if (s > mx) { const float f = __expf(mx - s); l *= f;
#pragma unroll
                for (int d = 0; d < 64; ++d) o[d] *= f;
                mx = s; }
            const float pp = __expf(s - mx); l += pp;
#pragma unroll
            for (int c = 0; c < 16; ++c) { const f32x4 vv = Vs[j * 16 + c]; o[4 * c] += pp * vv.x; o[4 * c + 1] += pp * vv.y; o[4 * c + 2] += pp * vv.z; o[4 * c + 3] += pp * vv.w; }
        }
    }
    if (sink) { const float sk = sink[h]; const float mf = fmaxf(mx, sk); const float f = __expf(mx - mf); l = l * f + __expf(sk - mf);
#pragma unroll
        for (int d = 0; d < 64; ++d) o[d] *= f; }
    const float rl = 1.f / l;
    u32x4* op = (u32x4*)(P_O(p) + (size_t)qrow * D + h * 64);
#pragma unroll
    for (int c = 0; c < 8; ++c) { u32x4 w; w.x = pk2(o[8 * c] * rl, o[8 * c + 1] * rl); w.y = pk2(o[8 * c + 2] * rl, o[8 * c + 3] * rl); w.z = pk2(o[8 * c + 4] * rl, o[8 * c + 5] * rl); w.w = pk2(o[8 * c + 6] * rl, o[8 * c + 7] * rl); op[c] = w; }
}

extern "C" void kernel_launch(void* const* d_in, const int* in_sizes, int n_in, void* d_out, int out_size, void* d_ws, size_t ws_size, hipStream_t stream) {
    if (n_in != 27 || out_size != ML * D || ws_size < WS_END) { fprintf(stderr, "kernel_launch: unexpected shapes (n_in %d out %d ws %zu need %zu)\n", n_in, out_size, ws_size, (size_t)WS_END); return; }
    Ptrs p{};
    for (int i = 0; i < 27; ++i) p.in[i] = (const float*)d_in[i];
    p.out = (float*)d_out; p.ws = (unsigned char*)d_ws;
    (void)hipMemsetAsync((char*)d_ws + WS_CTL, 0, CTL_BYTES, stream);
    k_mod<<<dim3(24, 4), 256, 0, stream>>>(p);
    k_input<<<256, 512, 0, stream>>>(p);
    const int MAXT = (M * TOPK) / TM + NE;
    for (int layer = 0; layer < DEPTH; ++layer) {
        const int kind = layer % 3, j = layer / 3; const bool need_ctx = layer < DEPTH - 1; const int rq = need_ctx ? M : ML;
        if (kind == 0) {
            k_gemm_dense<<<dim3(QKVD / 128, M / 128), 256, 0, stream>>>(P_H(p), p.in[10] + (size_t)j * D * QKVD, p.in[11] + (size_t)j * QKVD, P_BIG(p), QKVD, D);
            k_qk<0><<<256, 512, 0, stream>>>(p, nullptr, nullptr);
            k_attn_naive<0><<<dim3(need_ctx ? 17 : 16, 16, 8), 256, 0, stream>>>(p, p.in[12] + j * 16);
            k_gemm_dense<<<dim3(D / 128, rq / 128), 256, 0, stream>>>(P_O(p), p.in[13] + (size_t)j * D * D, nullptr, P_MX(p), D, D);
        } else if (kind == 1) {
            k_gemm_dense<<<dim3(3072 / 128, rq / 128), 256, 0, stream>>>(P_H(p), p.in[14] + (size_t)j * D * 3072, nullptr, P_BIG(p), 3072, D);
            k_conv<<<256, 512, 0, stream>>>(p, p.in[15] + (size_t)j * 3 * D, rq);
            k_gemm_dense<<<dim3(D / 128, rq / 128), 256, 0, stream>>>(P_O(p), p.in[16] + (size_t)j * D * D, nullptr, P_MX(p), D, D);
        } else {
            k_gemm_dense<<<dim3(QKVD / 128, M / 128), 256, 0, stream>>>(P_H(p), p.in[17] + (size_t)j * D * QKVD, nullptr, P_BIG(p), QKVD, D);
            k_qk<2><<<256, 512, 0, stream>>>(p, p.in[18] + j * 64, p.in[19] + j * 64);
            k_attn_naive<2><<<dim3(need_ctx ? 17 : 16, 16, 8), 256, 0, stream>>>(p, nullptr);
            k_gemm_dense<<<dim3(D / 128, rq / 128), 256, 0, stream>>>(P_O(p), p.in[20] + (size_t)j * D * D, nullptr, P_MX(p), D, D);
        }
        k_ln1<<<256, 512, 0, stream>>>(p, layer, rq);
        k_moe_up<<<dim3(DFF / 64, MAXT), 256, 0, stream>>>(p, layer);
        k_moe_down<<<dim3(D / 128, MAXT), 256, 0, stream>>>(p, layer);
        k_ln2<<<256, 512, 0, stream>>>(p, layer, rq);
    }
}
```

```cpp
#include <hip/hip_runtime.h>
#include <cstdio>
#include <cstdint>
#include <cmath>
#include <hip/hip_bf16.h>

#define LAS __attribute__((address_space(3)))
typedef unsigned short bf16;
typedef short bf16x8 __attribute__((ext_vector_type(8)));
typedef float f32x4 __attribute__((ext_vector_type(4)));
typedef float f32x2 __attribute__((ext_vector_type(2)));
typedef unsigned u32x4 __attribute__((ext_vector_type(4)));
typedef unsigned u32x2 __attribute__((ext_vector_type(2)));

constexpr int D = 1024, NB = 8, SEQ = 4096, CL = 256, ML = NB * SEQ, MZ = NB * CL, M = ML + MZ, DEPTH = 4;
constexpr int NE = 32, TOPK = 4, DFF = 1024, QKVD = 1536;
constexpr int CAP = M;
constexpr int TM = 256;
constexpr int PMAX = 147456;
constexpr float DN_ALPHA = 1.681792830507429f;
constexpr float LN_EPS = 1e-5f, RMS_EPS = 1e-6f;

constexpr size_t MiB = 1u << 20;
constexpr size_t WS_CTL = 0, CTL_BYTES = 1 * MiB;
constexpr size_t WS_MOD = 1 * MiB;
constexpr size_t WS_ROPE = 2 * MiB;
constexpr size_t WS_ASG = 3 * MiB;
constexpr size_t WS_GATE = 4 * MiB;
constexpr size_t WS_TOKL = 5 * MiB;
constexpr size_t WS_X = 16 * MiB;
constexpr size_t WS_H = WS_X + 136 * MiB;
constexpr size_t WS_BIG = WS_H + 68 * MiB;
constexpr size_t WS_O = WS_BIG + 204 * MiB;
constexpr size_t WS_MX = WS_O + 68 * MiB;
constexpr size_t WS_ACT = WS_MX + 68 * MiB;
constexpr size_t WS_OUTE = WS_ACT + 288 * MiB;
constexpr size_t WS_WT = WS_OUTE + 288 * MiB;
constexpr int WT_WINQKV = 0, WT_WINWO = 3072, WT_CONVIN = 5120, WT_CONVOUT = 8192, WT_FULLQKV = 9216, WT_FULLWO = 10752, WT_ROWS = 11776;
constexpr size_t WS_WGU = WS_WT + 24 * MiB;
constexpr size_t WS_WDN = WS_WGU + 512 * MiB;
constexpr size_t WS_H8 = WS_WDN + 256 * MiB;
constexpr size_t WS_END = WS_H8 + 40 * MiB;
constexpr int CW_CNT = 64;
constexpr int CW_BAR = 4096;

__device__ __forceinline__ float bf2f(unsigned v) { return __uint_as_float(v << 16); }
__device__ __forceinline__ unsigned f2bf(float f) { unsigned u = __float_as_uint(f); return (u + 0x7fffu + ((u >> 16) & 1u)) >> 16; }
typedef __bf16 bf16x2_hw __attribute__((ext_vector_type(2)));
__device__ __forceinline__ unsigned pk2(float lo, float hi) { const f32x2 v = {lo, hi}; return __builtin_bit_cast(unsigned, __builtin_convertvector(v, bf16x2_hw)); }
__device__ __forceinline__ unsigned pk4_fp8(float a, float b, float c, float d) { int w = __builtin_amdgcn_cvt_pk_fp8_f32(a, b, 0, false); w = __builtin_amdgcn_cvt_pk_fp8_f32(c, d, w, true); return (unsigned)w; }
constexpr int WTAB_LDS = 131072 + 3584;
__device__ __forceinline__ unsigned hw_slot() { return (unsigned)__builtin_amdgcn_s_getreg((5 << 11) | 4) & 63u; }
__device__ __forceinline__ int tidx() {
    extern __shared__ __attribute__((aligned(16))) unsigned char lds_raw[];
    const int w = __builtin_amdgcn_readfirstlane(*(const LAS int*)((LAS unsigned char*)lds_raw + WTAB_LDS + 4 * hw_slot()));
    int t = (w << 6) | (int)__builtin_amdgcn_mbcnt_hi(~0u, __builtin_amdgcn_mbcnt_lo(~0u, 0u));
    asm volatile("" : "+v"(t)); return t; }
__device__ __forceinline__ int lane_op() { int l = (int)__builtin_amdgcn_mbcnt_hi(~0u, __builtin_amdgcn_mbcnt_lo(~0u, 0u)); asm volatile("" : "+v"(l)); return l; }
__device__ __forceinline__ float shx(float v, int o, int l) { return __int_as_float(__builtin_amdgcn_ds_bpermute((l ^ o) << 2, __float_as_int(v))); }
template <int CTRL> __device__ __forceinline__ float dppf(float v) { return __builtin_bit_cast(float, __builtin_amdgcn_update_dpp(0, __builtin_bit_cast(int, v), CTRL, 0xF, 0xF, false)); }
__device__ __forceinline__ float wave_sum(float v) {
    v += dppf<0xB1>(v); v += dppf<0x4E>(v); v += dppf<0x124>(v); v += dppf<0x128>(v);
    { const auto r = __builtin_amdgcn_permlane16_swap(__float_as_uint(v), __float_as_uint(v), false, false); v = __uint_as_float(r[0]) + __uint_as_float(r[1]); }
    { const auto r = __builtin_amdgcn_permlane32_swap(__float_as_uint(v), __float_as_uint(v), false, false); v = __uint_as_float(r[0]) + __uint_as_float(r[1]); }
    return v;
}
__device__ __forceinline__ int mod_row(int row) { return row < ML ? (row >> 12) : 8; }
__device__ __forceinline__ f32x4 bf4(u32x2 w) { return (f32x4){bf2f(w.x & 0xffffu), bf2f(w.x >> 16), bf2f(w.y & 0xffffu), bf2f(w.y >> 16)}; }
__device__ __forceinline__ u32x2 pk4(f32x4 v) { u32x2 w; w.x = pk2(v.x, v.y); w.y = pk2(v.z, v.w); return w; }

struct Ptrs {
    const float* in[27];
    float* out;
    unsigned char* ws;
};
#define P_X(p) ((bf16*)((p).ws + WS_X))
#define P_H(p) ((bf16*)((p).ws + WS_H))
#define P_BIG(p) ((bf16*)((p).ws + WS_BIG))
#define P_O(p) ((bf16*)((p).ws + WS_O))
#define P_MX(p) ((bf16*)((p).ws + WS_MX))
#define P_ACT(p) ((bf16*)((p).ws + WS_ACT))
#define P_OUTE(p) ((bf16*)((p).ws + WS_OUTE))
#define P_MOD(p) ((float*)((p).ws + WS_MOD))
#define P_ROPE(p) ((f32x2*)((p).ws + WS_ROPE))
#define P_ASG(p) ((int*)((p).ws + WS_ASG))
#define P_GATE(p) ((float*)((p).ws + WS_GATE))
#define P_TOKL(p) ((int*)((p).ws + WS_TOKL))
#define P_CTL(p) ((unsigned*)((p).ws + WS_CTL))
#define P_WT(p) ((bf16*)((p).ws + WS_WT))
#define P_WGU(p) ((bf16*)((p).ws + WS_WGU))
#define P_WDN(p) ((bf16*)((p).ws + WS_WDN))
#define P_H8(p) ((unsigned char*)((p).ws + WS_H8))
#define P_WGU8(p) ((unsigned char*)((p).ws + WS_WGU))
#define P_WDN8(p) ((unsigned char*)((p).ws + WS_WDN))
#define P_ACT8(p) ((unsigned char*)((p).ws + WS_ACT))
#define P_OUTE8(p) ((unsigned char*)((p).ws + WS_OUTE))
#define P_O8(p) ((unsigned char*)((p).ws + WS_O))
#define P_WO8(p) ((unsigned char*)((p).ws + WS_H8 + 35 * MiB))
constexpr unsigned G1F8 = 0b101;
#define P_H8A(p) ((unsigned char*)((p).ws + WS_H))
#define P_WQ8W(p, j) ((unsigned char*)((p).ws + WS_WT) + (size_t)WT_WINWO * D * 2 + (size_t)(j) * QKVD * D)
#define P_WQ8F(p) ((unsigned char*)((p).ws + WS_WT) + (size_t)WT_FULLWO * D * 2)
constexpr float OSC_ATT = 16.f, OSC_CONV = 8.f;


constexpr int LDS_CTL = 131072;
constexpr int LC_BAR = 0, LC_LCNT = 64, LC_LBASE = 192, LC_PST = 320, LC_CNT = 448, LC_TILE0 = 576, LC_LASG = 1024;
constexpr int LC_WTAB = 3584;
static_assert(WTAB_LDS == LDS_CTL + LC_WTAB, "tidx table");
constexpr int LC_UINFO = 720;
constexpr int LC_TOKT = 4096;
constexpr int LC_BIAS = 13312;
constexpr int LDS_BYTES = 163840;
constexpr int NTHR = 512;

#define XB_TMO      128
#define XB_XCNT(j)  (256  + 64 * (j))
#define XB_XSUB(j)  (1280 + 64 * (j))
#define XB_XGEN(j)  (2304 + 64 * (j))
#define XB_TOP      3328
#define XB_TOPGEN   3392
#define XCD_BAR_WORDS 3456
#define XB_SPIN_CAP (1u << 18)

__device__ __forceinline__ unsigned xb_ld(unsigned* p)              { return __hip_atomic_load(p, __ATOMIC_RELAXED, __HIP_MEMORY_SCOPE_AGENT); }
__device__ __forceinline__ unsigned xb_add(unsigned* p, unsigned v) { return __hip_atomic_fetch_add(p, v, __ATOMIC_RELAXED, __HIP_MEMORY_SCOPE_AGENT); }
__device__ __forceinline__ unsigned xb_xcc_id() { return (unsigned)__builtin_amdgcn_s_getreg((3 << 11) | 20) & 0xFu; }
#define XB_SPIN(cond, bar) do { unsigned _sp = 0; while (cond) { __builtin_amdgcn_s_sleep(1); \
    if ((++_sp & 255u) == 0u) { if (xb_ld(&(bar)[XB_TMO])) break; if (_sp > XB_SPIN_CAP) { atomicAdd(&(bar)[XB_TMO], 1u); break; } } } } while (0)

struct XcdBarrier {
    unsigned* bar; unsigned x;
    volatile LAS unsigned* st;
};

__device__ __forceinline__ XcdBarrier xcd_barrier_post(unsigned* bar, volatile LAS unsigned* st) {
    XcdBarrier b; b.bar = bar; b.x = xb_xcc_id(); b.st = st;
    if (tidx() == 0) (void)xb_add(&bar[XB_XCNT(b.x)], 1u);
    return b;
}
__device__ __forceinline__ void xcd_barrier_complete(unsigned* bar, unsigned x, unsigned& nloc, unsigned& nx) {
    const unsigned G = gridDim.x * gridDim.y * gridDim.z;
    unsigned sum, cnt, mine, sp = 0u;
    for (;;) {
        sum = 0u; cnt = 0u; mine = 0u;
#pragma unroll
        for (unsigned j = 0; j < 16; ++j) { const unsigned c = xb_ld(&bar[XB_XCNT(j)]); sum += c; cnt += (c > 0u) ? 1u : 0u; mine = (j == x) ? c : mine; }
        if (sum == G) break;
        __builtin_amdgcn_s_sleep(1);
        if ((++sp & 255u) == 0u) { if (xb_ld(&bar[XB_TMO])) break; if (sp > XB_SPIN_CAP) { atomicAdd(&bar[XB_TMO], 1u); break; } }
    }
    nloc = mine > 0u ? mine : 1u; nx = cnt > 0u ? cnt : 1u;
}

struct XbTicket { unsigned gen, tg; int role; };
__device__ __forceinline__ XbTicket xcd_arrive(const XcdBarrier& b) {
    XbTicket t; t.gen = 0u; t.tg = 0u; t.role = 0;
    asm volatile("s_waitcnt vmcnt(0)" ::: "memory");
    __syncthreads();
    if (tidx() == 0) {
        unsigned* bar = b.bar; asm volatile("" : "+s"(bar)); const unsigned bx = __builtin_amdgcn_readfirstlane(b.x);
        __builtin_amdgcn_s_waitcnt(0);
        unsigned nloc = b.st[0], nx = b.st[1];
        if (nloc == 0u) { xcd_barrier_complete(bar, bx, nloc, nx); b.st[0] = nloc; b.st[1] = nx; }
        const unsigned old = xb_add(&bar[XB_XSUB(bx)], 1u);
        const unsigned gen = old / nloc; t.gen = gen;
        if (old + 1u == (gen + 1u) * nloc) {
            __builtin_amdgcn_fence(__ATOMIC_RELEASE, "agent");
            asm volatile("s_waitcnt vmcnt(0)" ::: "memory");
            const unsigned og = xb_add(&bar[XB_TOP], 1u);
            const unsigned tg = og / nx; t.tg = tg; t.role = 1;
            if (og + 1u == (tg + 1u) * nx) { xb_add(&bar[XB_TOPGEN], 1u); t.role = 2; }
        }
    }
    return t;
}
__device__ __forceinline__ void xcd_wait(const XcdBarrier& b, const XbTicket& t) {
    if (tidx() == 0) {
        unsigned* bar = b.bar; asm volatile("" : "+s"(bar)); const unsigned bx = __builtin_amdgcn_readfirstlane(b.x);
        if (t.role != 0) {
            if (t.role == 1) XB_SPIN(xb_ld(&bar[XB_TOPGEN]) == t.tg, bar);
            __builtin_amdgcn_fence(__ATOMIC_ACQUIRE, "agent");
            xb_add(&bar[XB_XGEN(bx)], 1u);
            asm volatile("s_waitcnt vmcnt(0)" ::: "memory");
        } else {
            XB_SPIN(xb_ld(&bar[XB_XGEN(bx)]) == t.gen, bar);
            __builtin_amdgcn_fence(__ATOMIC_ACQUIRE, "agent");
            asm volatile("s_waitcnt vmcnt(0)" ::: "memory");
        }
    }
    __syncthreads();
}

__device__ __forceinline__ void ph_mod(const Ptrs& p, LAS unsigned char* lds) {
    const int TX = tidx();
    LAS float* s = (LAS float*)lds; LAS float* red = (LAS float*)(lds + 36864);
    for (int i = TX; i < 9 * 1024; i += NTHR) { const int r = i >> 10, k = i & 1023; const float v = r < 8 ? p.in[1][r * 1024 + k] : p.in[3][k]; s[i] = v / (1.f + __expf(-v)); }
    __syncthreads();
    const int n = TX & 63, ks = TX >> 6;
    for (int item = blockIdx.x; item < 384; item += gridDim.x) {
        const int l = item / 96, nc = item % 96;
        float acc[9];
#pragma unroll
        for (int r = 0; r < 9; ++r) acc[r] = 0.f;
        const float* w = p.in[4] + ((size_t)l * 1024 + ks * 128) * 6144 + nc * 64 + n; const LAS float* sk = s + ks * 128;
#pragma unroll 16
        for (int k = 0; k < 128; ++k) { const float wv = w[(size_t)k * 6144];
#pragma unroll
            for (int r = 0; r < 9; ++r) acc[r] += sk[r * 1024 + k] * wv; }
#pragma unroll
        for (int r = 0; r < 9; ++r) red[(ks * 9 + r) * 64 + n] = acc[r];
        __syncthreads();
        for (int idx = TX; idx < 576; idx += NTHR) { const int r = idx >> 6, nn = idx & 63; float a = p.in[5][l * 6144 + nc * 64 + nn];
#pragma unroll
            for (int q = 0; q < 8; ++q) a += red[(q * 9 + r) * 64 + nn];
            P_MOD(p)[((size_t)l * 9 + r) * 6144 + nc * 64 + nn] = a; }
        __syncthreads();
    }
    if (blockIdx.x == gridDim.x - 1) {
        for (int i = TX; i < 64 * 16; i += NTHR) { const int pos = i >> 4, f = i & 15; const float inv = exp2f(-(float)f * (1.f / 16.f) * 13.287712379549449f); const float a = (float)pos * inv;
            P_ROPE(p)[i] = (f32x2){cosf(a), sinf(a)}; }
    }
    __syncthreads();
}

#define ROW_LOOP(nrows) const int tx_ = tidx(), lane = tx_ & 63, wave = tx_ >> 6, nwv = NTHR >> 6; for (int row = blockIdx.x * nwv + wave; row < (nrows); row += gridDim.x * nwv)
#define PAIR_LOOP(nrows) const int tx_ = tidx(), lane = tx_ & 63, wave = tx_ >> 6, rstride = (int)gridDim.x * 8; for (int row0 = blockIdx.x * 8 + wave, it = 0; row0 < (nrows); row0 += 2 * rstride, it += 2)
#define PAIR_ROWS(nrows) int row[2]; row[0] = row0; row[1] = row0 + rstride; const bool ok1 = row[1] < (nrows); if (!ok1) row[1] = row0
__device__ __forceinline__ void ld_bf8(const bf16* rowp, int lane, int jj, float (&o)[8]) { const u32x4 w = *(const u32x4*)(rowp + 8 * (lane + 64 * jj));
    o[0] = bf2f(w.x & 0xffffu); o[1] = bf2f(w.x >> 16); o[2] = bf2f(w.y & 0xffffu); o[3] = bf2f(w.y >> 16); o[4] = bf2f(w.z & 0xffffu); o[5] = bf2f(w.z >> 16); o[6] = bf2f(w.w & 0xffffu); o[7] = bf2f(w.w >> 16); }
__device__ __forceinline__ void ld_q8(const unsigned char* rowp, int lane, int jj, float (&o)[8]) { const u32x2 w = *(const u32x2*)(rowp + 8 * (lane + 64 * jj));
    const f32x2 a = __builtin_amdgcn_cvt_pk_f32_fp8((int)w.x, false), b = __builtin_amdgcn_cvt_pk_f32_fp8((int)w.x, true), c = __builtin_amdgcn_cvt_pk_f32_fp8((int)w.y, false), d = __builtin_amdgcn_cvt_pk_f32_fp8((int)w.y, true);
    o[0] = a.x; o[1] = a.y; o[2] = b.x; o[3] = b.y; o[4] = c.x; o[5] = c.y; o[6] = d.x; o[7] = d.y; }
__device__ __forceinline__ void un_bf8(const u32x4 w, float (&o)[8]) { o[0] = bf2f(w.x & 0xffffu); o[1] = bf2f(w.x >> 16); o[2] = bf2f(w.y & 0xffffu); o[3] = bf2f(w.y >> 16); o[4] = bf2f(w.z & 0xffffu); o[5] = bf2f(w.z >> 16); o[6] = bf2f(w.w & 0xffffu); o[7] = bf2f(w.w >> 16); }
__device__ __forceinline__ void ld_f8(const float* rowp, int lane, int jj, float (&o)[8]) { const f32x4 a = *(const f32x4*)(rowp + 8 * (lane + 64 * jj)), b = *(const f32x4*)(rowp + 8 * (lane + 64 * jj) + 4);
    o[0] = a.x; o[1] = a.y; o[2] = a.z; o[3] = a.w; o[4] = b.x; o[5] = b.y; o[6] = b.z; o[7] = b.w; }
__device__ __forceinline__ void st_bf8(bf16* rowp, int lane, int jj, const float (&v)[8]);
__device__ __forceinline__ void st_bf8(bf16* rowp, int lane, int jj, const float (&v)[8]) { u32x4 w; w.x = pk2(v[0], v[1]); w.y = pk2(v[2], v[3]); w.z = pk2(v[4], v[5]); w.w = pk2(v[6], v[7]); *(u32x4*)(rowp + 8 * (lane + 64 * jj)) = w; }
__device__ __forceinline__ void st_h(unsigned char* hbase, int row, int lane, int jj, const float (&h)[8], bool f8) {
    asm volatile("" : "+v"(lane));
    if (f8) { u32x2 w; w.x = pk4_fp8(h[0], h[1], h[2], h[3]); w.y = pk4_fp8(h[4], h[5], h[6], h[7]); *(u32x2*)(hbase + (size_t)row * D + 8 * (lane + 64 * jj)) = w; }
    else st_bf8((bf16*)hbase + (size_t)row * D, lane, jj, h); }
__device__ __forceinline__ void st_f8(float* rowp, int lane, int jj, const float (&v)[8]) { *(f32x4*)(rowp + 8 * (lane + 64 * jj)) = (f32x4){v[0], v[1], v[2], v[3]}; *(f32x4*)(rowp + 8 * (lane + 64 * jj) + 4) = (f32x4){v[4], v[5], v[6], v[7]}; }

__device__ __forceinline__ void ph_input(const Ptrs& p) {
    {
        const int tx0 = tidx(), ln0 = tx0 & 63, gw = blockIdx.x * 8 + (tx0 >> 6), NGW = gridDim.x * 8; float* RAB = (float*)(p.ws + WS_MOD + 896 * 1024);
        for (int it = gw; it < 1152; it += NGW) { const int e = it & 31, lm = it >> 5, layer = lm / 9;
            const float* md = P_MOD(p) + (size_t)lm * 6144; const float* g = p.in[6] + layer * D; const float* bb = p.in[7] + layer * D; const float* rw = p.in[21] + (size_t)layer * D * NE;
            float sa = 0.f, sb = 0.f;
            for (int k = ln0; k < D; k += 64) { const float w = rw[(size_t)k * NE + e], sc = md[4096 + k], sh = md[3072 + k]; sa += g[k] * (1.f + sc) * w; sb += (bb[k] * (1.f + sc) + sh) * w; }
            sa = wave_sum(sa); sb = wave_sum(sb);
            if (ln0 == 0) { RAB[it] = sa; RAB[1152 + it] = sb + p.in[22][layer * NE + e]; } }
    }
    PAIR_LOOP(M) { PAIR_ROWS(M);
#pragma unroll
        for (int r = 0; r < 2; ++r) {
            const float* src = row[r] < ML ? p.in[0] + (size_t)row[r] * D : p.in[2] + (size_t)(row[r] - ML) * D; const float* md = P_MOD(p) + (size_t)mod_row(row[r]) * 6144;
#pragma unroll
            for (int jj = 0; jj < 2; ++jj) { float v[8], sh[8], sc[8], h[8]; ld_f8(src, lane, jj, v); ld_f8(md, lane, jj, sh); ld_f8(md + 1024, lane, jj, sc);
#pragma unroll
                for (int i = 0; i < 8; ++i) h[i] = v[i] * (1.f + sc[i]) + sh[i];
                if (r == 0 || ok1) { st_bf8(P_X(p) + (size_t)row[r] * D, lane, jj, v); st_h((unsigned char*)P_H(p), row[r], lane, jj, h, (G1F8 & 1u) != 0u); } }
        }
    }
}

template <int KIND> __device__ __forceinline__ void ph_kproc(const Ptrs& p, const float* kn) {
    PAIR_LOOP(M) { PAIR_ROWS(M);
        const int l16 = lane & 15;
#pragma unroll
        for (int r = 0; r < 2; ++r) {
            bf16* kp = P_BIG(p) + (size_t)row[r] * QKVD + 1024 + lane * 4; const u32x2 w = *(const u32x2*)kp;
            float v[4]; v[0] = bf2f(w.x & 0xffffu); v[1] = bf2f(w.x >> 16); v[2] = bf2f(w.y & 0xffffu); v[3] = bf2f(w.y >> 16);
            if (KIND == 2) { float ss = (v[0] * v[0] + v[1] * v[1]) + (v[2] * v[2] + v[3] * v[3]); { const int l_ = lane_op(); ss += shx(ss, 1, l_); ss += shx(ss, 2, l_); ss += shx(ss, 4, l_); ss += shx(ss, 8, l_); }
                const float rs = 1.0f / sqrtf(ss * (1.f / 64.f) + RMS_EPS); const f32x4 g = *(const f32x4*)(kn + 4 * l16);
                v[0] *= rs * g.x; v[1] *= rs * g.y; v[2] *= rs * g.z; v[3] *= rs * g.w; }
            if (row[r] < ML) { const int t = row[r] & 4095, axis = l16 >> 3, half = (l16 >> 2) & 1, pos = axis ? (t & 63) : (t >> 6);
                const f32x4* cp = (const f32x4*)(P_ROPE(p) + pos * 16 + 4 * (l16 & 3)); const f32x4 c01 = cp[0], c23 = cp[1];
                const float cs[4] = {c01.x, c01.z, c23.x, c23.z}, sn[4] = {c01.y, c01.w, c23.y, c23.w};
#pragma unroll
                for (int i = 0; i < 4; ++i) { const float o = shx(v[i], 4, lane_op()); v[i] = half == 0 ? v[i] * cs[i] - o * sn[i] : v[i] * cs[i] + o * sn[i]; } }
            if (r == 0 || ok1) { u32x2 o; o.x = pk2(v[0], v[1]); o.y = pk2(v[2], v[3]); *(u32x2*)kp = o; }
        }
    }
}

__device__ __forceinline__ void ph_conv(const Ptrs& p, const float* cw, int nrows) {
    PAIR_LOOP(nrows) { PAIR_ROWS(nrows);
#pragma unroll
        for (int r = 0; r < 2; ++r) {
            const int t = row[r] < ML ? (row[r] & 4095) : ((row[r] - ML) & 255), tl = row[r] < ML ? 4095 : 255;
            const bool vp = t != 0, vn = t != tl;
            const bf16* u = P_BIG(p) + (size_t)row[r] * 3072;
#pragma unroll
            for (int jj = 0; jj < 2; ++jj) {
                float b[8], c0[8], x0[8], cp[8], xp[8], cn[8], xn[8], w0[8], w1[8], w2[8], y[8];
                ld_bf8(u, lane, jj, b); ld_bf8(u + 1024, lane, jj, c0); ld_bf8(u + 2048, lane, jj, x0);
#pragma unroll
                for (int i = 0; i < 8; ++i) { cp[i] = 0.f; xp[i] = 0.f; cn[i] = 0.f; xn[i] = 0.f; }
                if (vp) { ld_bf8(u - 3072 + 1024, lane, jj, cp); ld_bf8(u - 3072 + 2048, lane, jj, xp); }
                if (vn) { ld_bf8(u + 3072 + 1024, lane, jj, cn); ld_bf8(u + 3072 + 2048, lane, jj, xn); }
                ld_f8(cw, lane, jj, w0); ld_f8(cw + 1024, lane, jj, w1); ld_f8(cw + 2048, lane, jj, w2);
#pragma unroll
                for (int i = 0; i < 8; ++i) y[i] = b[i] * (w0[i] * (cp[i] * xp[i]) + w1[i] * (c0[i] * x0[i]) + w2[i] * (cn[i] * xn[i]));
                if (r == 0 || ok1) { float c8[8];
#pragma unroll
                    for (int i = 0; i < 8; ++i) c8[i] = fminf(fmaxf(y[i] * OSC_CONV, -448.f), 448.f);
                    u32x2 w8; w8.x = pk4_fp8(c8[0], c8[1], c8[2], c8[3]); w8.y = pk4_fp8(c8[4], c8[5], c8[6], c8[7]); *(u32x2*)(P_O8(p) + (size_t)row[r] * D + 8 * (lane + 64 * jj)) = w8; }
            }
        }
    }
}

constexpr int MAXR = 160;
#define P_RAB(p) ((float*)((p).ws + WS_MOD + 896 * 1024))
__device__ __forceinline__ void ph_ln1_pro(const Ptrs& p, int layer, LAS int* lcnt  , bf16x8 (&wh)[4][2], bf16x8 (&wl)[4][2]) {
    const int TX = tidx(), lane = TX & 63, wave = TX >> 6;
    const float* rw = p.in[21] + (size_t)layer * D * NE;
    if (TX < 32) lcnt[TX] = 0;
    { const int r = lane & 15, kb = 128 * wave + 8 * (lane >> 4);
#pragma unroll
    for (int ks = 0; ks < 4; ++ks)
#pragma unroll
        for (int eb = 0; eb < 2; ++eb) { u32x4 h4, l4;
#pragma unroll
            for (int i = 0; i < 4; ++i) { const float w0 = rw[(size_t)(kb + 32 * ks + 2 * i) * NE + 16 * eb + r], w1 = rw[(size_t)(kb + 32 * ks + 2 * i + 1) * NE + 16 * eb + r];
                const unsigned hp = pk2(w0, w1); h4[i] = hp; l4[i] = pk2(w0 - __uint_as_float(hp << 16), w1 - __uint_as_float(hp & 0xffff0000u)); }
            wh[ks][eb] = __builtin_bit_cast(bf16x8, h4); wl[ks][eb] = __builtin_bit_cast(bf16x8, l4); } }
}
__device__ __forceinline__ void ph_ln1(const Ptrs& p, int layer, int nrows, LAS int* lcnt  , LAS int* lbase  , LAS int* lasg  , LAS unsigned char* lds  , const bf16x8 (&wh)[4][2], const bf16x8 (&wl)[4][2]) {
    const int TX = tidx(), lane = TX & 63, wave = TX >> 6;
    const float* g = p.in[6] + layer * D; const float* bb = p.in[7] + layer * D;
    unsigned* cnt = P_CTL(p) + CW_CNT + layer * 64;
    __syncthreads();
    const int ngr = nrows >> 4, G = (int)gridDim.x;
    LAS float* part = (LAS float*)lds;
    LAS float* stat = (LAS float*)(lds + 32768);
    const float* RAB = P_RAB(p) + layer * 288;
    u32x4 xq[4], mq[4];
    { const size_t ro = (size_t)(blockIdx.x * 16 + (lane & 15)) * D + 128 * wave + 8 * (lane >> 4);
#pragma unroll
      for (int ks = 0; ks < 4; ++ks) { xq[ks] = *(const u32x4*)(P_X(p) + ro + 32 * ks); mq[ks] = *(const u32x4*)(P_MX(p) + ro + 32 * ks); } }
    int gi = 0;
    for (int gq = blockIdx.x; gq < ngr; gq += G, ++gi) {
        int lx = lane; asm volatile("" : "+v"(lx));
        const int r = lx & 15, q = lx >> 4, kb = 128 * wave + 8 * q;
        const int mr = mod_row(gq * 16); const float* md = P_MOD(p) + ((size_t)layer * 9 + mr) * 6144;
        const float ra_ = RAB[mr * 32 + (lx & 31)], rb_ = RAB[1152 + mr * 32 + (lx & 31)];
        float y[4][8]; float s1 = 0.f, s2 = 0.f;
#pragma unroll
        for (int ks = 0; ks < 4; ++ks) { float x[8], m[8]; const f32x4 ga = *(const f32x4*)(md + 2048 + kb + 32 * ks), gb = *(const f32x4*)(md + 2048 + kb + 32 * ks + 4);
            const float g1[8] = {ga.x, ga.y, ga.z, ga.w, gb.x, gb.y, gb.z, gb.w}; un_bf8(xq[ks], x); un_bf8(mq[ks], m);
#pragma unroll
            for (int i = 0; i < 8; ++i) { const float v = x[i] * DN_ALPHA + g1[i] * m[i]; y[ks][i] = v; s1 += v; s2 += v * v; } }
        __builtin_amdgcn_sched_barrier(0);
        { const int gn = gq + G; if (gn < ngr) { const size_t ro = (size_t)(gn * 16 + r) * D + kb;
#pragma unroll
            for (int ks = 0; ks < 4; ++ks) { xq[ks] = *(const u32x4*)(P_X(p) + ro + 32 * ks); mq[ks] = *(const u32x4*)(P_MX(p) + ro + 32 * ks); } } }
        __builtin_amdgcn_sched_barrier(0);
        f32x4 acc[2] = {(f32x4){0.f, 0.f, 0.f, 0.f}, (f32x4){0.f, 0.f, 0.f, 0.f}};
#pragma unroll
        for (int ks = 0; ks < 4; ++ks) { const f32x4 ga = *(const f32x4*)(g + kb + 32 * ks), gb = *(const f32x4*)(g + kb + 32 * ks + 4), ca = *(const f32x4*)(md + 4096 + kb + 32 * ks), cb = *(const f32x4*)(md + 4096 + kb + 32 * ks + 4);
            const float a[8] = {ga.x * (1.f + ca.x), ga.y * (1.f + ca.y), ga.z * (1.f + ca.z), ga.w * (1.f + ca.w), gb.x * (1.f + cb.x), gb.y * (1.f + cb.y), gb.z * (1.f + cb.z), gb.w * (1.f + cb.w)};
            u32x4 zh, zl;
#pragma unroll
            for (int i = 0; i < 4; ++i) { const float z0 = y[ks][2 * i] * a[2 * i], z1 = y[ks][2 * i + 1] * a[2 * i + 1]; const unsigned hp = pk2(z0, z1);
                zh[i] = hp; zl[i] = pk2(z0 - __uint_as_float(hp << 16), z1 - __uint_as_float(hp & 0xffff0000u)); }
            const bf16x8 zhv = __builtin_bit_cast(bf16x8, zh), zlv = __builtin_bit_cast(bf16x8, zl);
#pragma unroll
            for (int eb = 0; eb < 2; ++eb) {
                acc[eb] = __builtin_amdgcn_mfma_f32_16x16x32_bf16(wh[ks][eb], zhv, acc[eb], 0, 0, 0);
                acc[eb] = __builtin_amdgcn_mfma_f32_16x16x32_bf16(wl[ks][eb], zhv, acc[eb], 0, 0, 0);
                acc[eb] = __builtin_amdgcn_mfma_f32_16x16x32_bf16(wh[ks][eb], zlv, acc[eb], 0, 0, 0); } }
        s1 += shx(s1, 16, lx); s1 += shx(s1, 32, lx); s2 += shx(s2, 16, lx); s2 += shx(s2, 32, lx);
        const int buf = gi & 1;
        { LAS float* pw = part + ((buf * 8 + wave) * 16 + r) * 32 + 4 * q; *(LAS f32x4*)pw = acc[0]; *(LAS f32x4*)(pw + 16) = acc[1];
          if (q == 0) *(LAS f32x2*)(stat + ((buf * 8 + wave) * 16 + r) * 2) = (f32x2){s1, s2}; }
        __syncthreads();
        float t1 = 0.f, t2 = 0.f;
#pragma unroll
        for (int w = 0; w < 8; ++w) { const f32x2 sv = *(const LAS f32x2*)(stat + ((buf * 8 + w) * 16 + r) * 2); t1 += sv.x; t2 += sv.y; }
        const float mean = t1 * (1.f / D), rstd = 1.f / sqrtf(fmaxf(t2 * (1.f / D) - mean * mean, 0.f) + LN_EPS);
#pragma unroll
        for (int ks = 0; ks < 4; ++ks) { const int kc = kb + 32 * ks; float gg[8], gb[8], sc[8], sh[8], xn[8], hv[8];
            { const f32x4 a0 = *(const f32x4*)(g + kc), a1 = *(const f32x4*)(g + kc + 4), b0 = *(const f32x4*)(bb + kc), b1 = *(const f32x4*)(bb + kc + 4), c0 = *(const f32x4*)(md + 4096 + kc), c1 = *(const f32x4*)(md + 4096 + kc + 4), d0 = *(const f32x4*)(md + 3072 + kc), d1 = *(const f32x4*)(md + 3072 + kc + 4);
              gg[0] = a0.x; gg[1] = a0.y; gg[2] = a0.z; gg[3] = a0.w; gg[4] = a1.x; gg[5] = a1.y; gg[6] = a1.z; gg[7] = a1.w; gb[0] = b0.x; gb[1] = b0.y; gb[2] = b0.z; gb[3] = b0.w; gb[4] = b1.x; gb[5] = b1.y; gb[6] = b1.z; gb[7] = b1.w;
              sc[0] = c0.x; sc[1] = c0.y; sc[2] = c0.z; sc[3] = c0.w; sc[4] = c1.x; sc[5] = c1.y; sc[6] = c1.z; sc[7] = c1.w; sh[0] = d0.x; sh[1] = d0.y; sh[2] = d0.z; sh[3] = d0.w; sh[4] = d1.x; sh[5] = d1.y; sh[6] = d1.z; sh[7] = d1.w; }
#pragma unroll
            for (int i = 0; i < 8; ++i) { xn[i] = (y[ks][i] - mean) * rstd * gg[i] + gb[i]; hv[i] = xn[i] * (1.f + sc[i]) + sh[i]; }
            const size_t ro = (size_t)(gq * 16 + r) * D + kc;
            u32x4 xw; xw.x = pk2(xn[0], xn[1]); xw.y = pk2(xn[2], xn[3]); xw.z = pk2(xn[4], xn[5]); xw.w = pk2(xn[6], xn[7]); *(u32x4*)(P_X(p) + ro) = xw;
            u32x2 h8; h8.x = pk4_fp8(hv[0], hv[1], hv[2], hv[3]); h8.y = pk4_fp8(hv[4], hv[5], hv[6], hv[7]); *(u32x2*)(P_H8(p) + ro) = h8; }
        const int myid = lx & 31, rr = lx >> 5, lrow = 2 * wave + rr;
        float S = 0.f;
#pragma unroll
        for (int w = 0; w < 8; ++w) S += part[((buf * 8 + w) * 16 + lrow) * 32 + myid];
        const float mean_l = __int_as_float(__builtin_amdgcn_ds_bpermute(lrow << 2, __float_as_int(mean))), rstd_l = __int_as_float(__builtin_amdgcn_ds_bpermute(lrow << 2, __float_as_int(rstd)));
        float val = rstd_l * (S - mean_l * ra_) + rb_;
        LAS float* tot = (LAS float*)(lds + 36864) + lrow * 32;
        tot[myid] = val;
        asm volatile("s_waitcnt lgkmcnt(0)" ::: "memory");
        int rank = 0; float vmax = val;
#pragma unroll
        for (int j4 = 0; j4 < 8; ++j4) { const f32x4 t4 = *(const LAS f32x4*)(tot + 4 * j4); const float tj[4] = {t4.x, t4.y, t4.z, t4.w};
#pragma unroll
            for (int t = 0; t < 4; ++t) { const int j = 4 * j4 + t; rank += (tj[t] > val || (tj[t] == val && j < myid)) ? 1 : 0; vmax = fmaxf(vmax, tj[t]); } }
        const bool top = rank < 4;
        const float pe = top ? __expf(val - vmax) : 0.f; float ps = pe;
#pragma unroll
        for (int sft = 1; sft < 32; sft <<= 1) ps += shx(ps, sft, lx);
        if (top) { const int myrow = gq * 16 + lrow; const int lr = atomicAdd((int*)&lcnt[myid], 1); lasg[(gi * 16 + lrow) * 4 + rank] = myid | (lr << 8); P_GATE(p)[(size_t)myrow * 4 + rank] = pe / ps; }
    }
    __syncthreads();
    if (TX < 32) lbase[TX] = (int)__hip_atomic_fetch_add(cnt + TX, (unsigned)lcnt[TX], __ATOMIC_RELAXED, __HIP_MEMORY_SCOPE_AGENT);
    __syncthreads();
    for (int u = TX; u < gi * 64; u += NTHR) { const int li = u >> 2, row = ((int)blockIdx.x + (li >> 4) * G) * 16 + (li & 15);
        const int a = lasg[u]; const int e = a & 255, rk = lbase[e] + (a >> 8);
        P_ASG(p)[(size_t)row * 4 + (u & 3)] = e | (rk << 8); P_TOKL(p)[(size_t)e * CAP + rk] = row; }
}

__device__ __forceinline__ void ph_ln2(const Ptrs& p, int layer, int nrows, LAS int* pst  , const LAS int* tile0  , bool hf8  ) {
    const int TX = tidx();
    const float* g = p.in[8] + layer * D; const float* bb = p.in[9] + layer * D;
    const unsigned* cnt = P_CTL(p) + CW_CNT + layer * 64;
    if (TX < 32) pst[TX] = tile0[TX] * TM;
    __syncthreads();
    const bool last = layer == DEPTH - 1;
    typedef int i32x4 __attribute__((ext_vector_type(4)));
    const int tx_ = tidx(), lane = tx_ & 63, wave = tx_ >> 6, rstride = (int)gridDim.x * 8;
    i32x4 an[2]; f32x4 gn[2];
    { const int r0 = blockIdx.x * 8 + wave; if (r0 < nrows) { const int r1 = r0 + rstride < nrows ? r0 + rstride : r0;
        an[0] = *(const i32x4*)(P_ASG(p) + (size_t)r0 * 4); gn[0] = *(const f32x4*)(P_GATE(p) + (size_t)r0 * 4); an[1] = *(const i32x4*)(P_ASG(p) + (size_t)r1 * 4); gn[1] = *(const f32x4*)(P_GATE(p) + (size_t)r1 * 4); } }
    for (int row0 = blockIdx.x * 8 + wave; row0 < nrows; row0 += 2 * rstride) { PAIR_ROWS(nrows);
        i32x4 ac[2]; f32x4 gc[2]; ac[0] = an[0]; ac[1] = an[1]; gc[0] = gn[0]; gc[1] = gn[1];
        { const int n0 = row0 + 2 * rstride; if (n0 < nrows) { const int n1 = n0 + rstride < nrows ? n0 + rstride : n0;
            an[0] = *(const i32x4*)(P_ASG(p) + (size_t)n0 * 4); gn[0] = *(const f32x4*)(P_GATE(p) + (size_t)n0 * 4); an[1] = *(const i32x4*)(P_ASG(p) + (size_t)n1 * 4); gn[1] = *(const f32x4*)(P_GATE(p) + (size_t)n1 * 4); } }
        float v[2][2][8]; float s[2] = {0.f, 0.f};
#pragma unroll
        for (int r = 0; r < 2; ++r) {
            const float* md = P_MOD(p) + ((size_t)layer * 9 + mod_row(row[r])) * 6144;
            const i32x4 a = ac[r]; const f32x4 gt = gc[r];
#pragma unroll
            for (int jj = 0; jj < 2; ++jj)
#pragma unroll
                for (int i = 0; i < 8; ++i) v[r][jj][i] = 0.f;
            if (r == 1 && !ok1) continue;
#pragma unroll
            for (int k = 0; k < 4; ++k) { const int pos = pst[a[k] & 255] + (a[k] >> 8);
#pragma unroll
                for (int jj = 0; jj < 2; ++jj) { float o[8]; ld_q8(P_OUTE8(p) + (size_t)pos * D, lane, jj, o); const float gk = gt[k] * 0.25f;
#pragma unroll
                    for (int i = 0; i < 8; ++i) v[r][jj][i] += gk * o[i]; } }
#pragma unroll
            for (int jj = 0; jj < 2; ++jj) { float x[8], g2[8]; ld_bf8(P_X(p) + (size_t)row[r] * D, lane, jj, x); ld_f8(md + 5120, lane, jj, g2);
#pragma unroll
                for (int i = 0; i < 8; ++i) { v[r][jj][i] = x[i] * DN_ALPHA + g2[i] * v[r][jj][i]; s[r] += v[r][jj][i]; } }
        }
        float mean[2], rstd[2], s2[2] = {0.f, 0.f};
#pragma unroll
        for (int r = 0; r < 2; ++r) mean[r] = wave_sum(s[r]) * (1.f / D);
#pragma unroll
        for (int r = 0; r < 2; ++r)
#pragma unroll
            for (int jj = 0; jj < 2; ++jj)
#pragma unroll
                for (int i = 0; i < 8; ++i) { v[r][jj][i] -= mean[r]; s2[r] += v[r][jj][i] * v[r][jj][i]; }
#pragma unroll
        for (int r = 0; r < 2; ++r) rstd[r] = 1.f / sqrtf(wave_sum(s2[r]) * (1.f / D) + LN_EPS);
#pragma unroll
        for (int jj = 0; jj < 2; ++jj) { float gg[8], gb[8]; ld_f8(g, lane, jj, gg); ld_f8(bb, lane, jj, gb);
#pragma unroll
            for (int r = 0; r < 2; ++r) { float xn[8];
#pragma unroll
                for (int i = 0; i < 8; ++i) xn[i] = v[r][jj][i] * rstd[r] * gg[i] + gb[i];
                if (last) { if (r == 0 || ok1) st_f8(p.out + (size_t)row[r] * D, lane, jj, xn); }
                else { const float* mdn = P_MOD(p) + ((size_t)(layer + 1) * 9 + mod_row(row[r])) * 6144; float sh[8], sc[8], h[8]; ld_f8(mdn, lane, jj, sh); ld_f8(mdn + 1024, lane, jj, sc);
#pragma unroll
                    for (int i = 0; i < 8; ++i) h[i] = xn[i] * (1.f + sc[i]) + sh[i];
                    if (r == 0 || ok1) { st_bf8(P_X(p) + (size_t)row[r] * D, lane, jj, xn); st_h((unsigned char*)P_H(p), row[r], lane, jj, h, hf8); } } }
        }
    }
}


template <bool GU> __device__ __forceinline__ void tr_item(const float* W, int N, bf16* WT, int item, LAS unsigned char* t, int lane) {
    const int nb = N >> 6, k0 = (item / nb) * 64, n0 = (item % nb) * 64, q = lane >> 4, n4 = (lane & 15) * 4;
    f32x4 v[16];
#pragma unroll
    for (int i = 0; i < 16; ++i) v[i] = *(const f32x4*)(W + (size_t)(k0 + 16 * q + i) * N + n0 + n4);
#pragma unroll
    for (int j = 0; j < 4; ++j) {
        u32x4 a, b; a.x = pk2(v[0][j], v[1][j]); a.y = pk2(v[2][j], v[3][j]); a.z = pk2(v[4][j], v[5][j]); a.w = pk2(v[6][j], v[7][j]);
        b.x = pk2(v[8][j], v[9][j]); b.y = pk2(v[10][j], v[11][j]); b.z = pk2(v[12][j], v[13][j]); b.w = pk2(v[14][j], v[15][j]);
        *(LAS u32x4*)(t + (n4 + j) * 144 + q * 32) = a; *(LAS u32x4*)(t + (n4 + j) * 144 + q * 32 + 16) = b; }
    asm volatile("s_waitcnt lgkmcnt(0)" ::: "memory");
#pragma unroll
    for (int r = 0; r < 8; ++r) { const int nl = 8 * r + (lane >> 3), ch = lane & 7, n = n0 + nl;
        const int R = GU ? ((n & 1023) >> 7) * 256 + (n & 127) + (n >> 10) * 128 : n;
        *(u32x4*)(WT + (size_t)R * 1024 + k0 + ch * 8) = *(const LAS u32x4*)(t + nl * 144 + ch * 16); }
    asm volatile("s_waitcnt lgkmcnt(0)" ::: "memory");
}
template <bool GU> __device__ __forceinline__ void tr_item8(const float* W, int N, unsigned char* WT, float scale, int item, LAS unsigned char* t, int lane) {
    const int nb = N >> 6, pr = item >> 1, k0 = ((pr / nb) * 2 + (item & 1)) * 64, n0 = (pr % nb) * 64, q = lane >> 4, n4 = (lane & 15) * 4;
    f32x4 v[16];
#pragma unroll
    for (int i = 0; i < 16; ++i) v[i] = *(const f32x4*)(W + (size_t)(k0 + 16 * q + i) * N + n0 + n4) * scale;
#pragma unroll
    for (int j = 0; j < 4; ++j) { u32x4 a; a.x = pk4_fp8(v[0][j], v[1][j], v[2][j], v[3][j]); a.y = pk4_fp8(v[4][j], v[5][j], v[6][j], v[7][j]); a.z = pk4_fp8(v[8][j], v[9][j], v[10][j], v[11][j]); a.w = pk4_fp8(v[12][j], v[13][j], v[14][j], v[15][j]);
        *(LAS u32x4*)(t + (n4 + j) * 80 + q * 16) = a; }
    asm volatile("s_waitcnt lgkmcnt(0)" ::: "memory");
#pragma unroll
    for (int r = 0; r < 4; ++r) { const int nl = 16 * r + (lane >> 2), ch = lane & 3, n = n0 + nl;
        const int R = GU ? ((n & 1023) >> 7) * 256 + (n & 127) + (n >> 10) * 128 : n;
        *(u32x4*)(WT + (size_t)R * 1024 + k0 + ch * 16) = *(const LAS u32x4*)(t + nl * 80 + ch * 16); }
    asm volatile("s_waitcnt lgkmcnt(0)" ::: "memory");
}
__device__ __forceinline__ void ph_weights(const Ptrs& p, LAS unsigned char* lds) {
    const int TX = tidx(), lane = TX & 63, wave = TX >> 6, gw = blockIdx.x * 8 + wave, NGW = gridDim.x * 8;
    LAS unsigned char* t = lds + wave * 9216;
    constexpr int I15 = 16 * 24, I10 = 16 * 16, I30 = 16 * 48, I20 = 16 * 32;
    constexpr int NS = 2 * I15 + 2 * I10 + I30 + I10 + I15 + I10;
    for (int it = gw; it < NS; it += NGW) {
        int r = it; bf16* wt = P_WT(p);
        if (r < 2 * I15) { const int j = r / I15; if (G1F8 & 1u) tr_item8<false>(p.in[10] + (size_t)j * D * QKVD, QKVD, P_WQ8W(p, j), 32.f, r % I15, t, lane); else tr_item<false>(p.in[10] + (size_t)j * D * QKVD, QKVD, wt + (size_t)(WT_WINQKV + j * QKVD) * D, r % I15, t, lane); continue; } r -= 2 * I15;
        if (r < 2 * I10) { const int j = r / I10; tr_item8<false>(p.in[13] + (size_t)j * D * D, D, P_WO8(p) + (size_t)j * D * D, 64.f, r % I10, t, lane); continue; } r -= 2 * I10;
        if (r < I30) { tr_item<false>(p.in[14], 3072, wt + (size_t)WT_CONVIN * D, r, t, lane); continue; } r -= I30;
        if (r < I10) { tr_item8<false>(p.in[16], D, P_WO8(p) + (size_t)2 * D * D, 64.f, r, t, lane); continue; } r -= I10;
        if (r < I15) { if (G1F8 & 4u) tr_item8<false>(p.in[17], QKVD, P_WQ8F(p), 32.f, r, t, lane); else tr_item<false>(p.in[17], QKVD, wt + (size_t)WT_FULLQKV * D, r, t, lane); continue; } r -= I15;
        tr_item8<false>(p.in[20], D, P_WO8(p) + (size_t)3 * D * D, 64.f, r, t, lane);
    }
    for (int it = gw; it < 128 * I20; it += NGW) { const int mtx = it / I20; tr_item8<true>(p.in[23] + (size_t)mtx * D * 2 * DFF, 2 * DFF, P_WGU8(p) + (size_t)mtx * 2 * DFF * D, 32.f, it % I20, t, lane); }
    for (int it = gw; it < 128 * I10; it += NGW) { const int mtx = it / I10; tr_item8<false>(p.in[25] + (size_t)mtx * DFF * D, D, P_WDN8(p) + (size_t)mtx * D * DFF, 64.f, it % I10, t, lane); }
    __syncthreads();
}

namespace pg8 {
constexpr int BM = 256, BK = 64, HALF = 128, HTB = HALF * BK * 2, STAGE_BYTES = 8 * HTB, NXCD = 8, WGM = 8, K = 1024, NT = K / BK;
__host__ __device__ __forceinline__ int lds_byte(int r, int c) { const int st = (r >> 4) * 2 + (c >> 5), rr = r & 15, cc = c & 31, ob = rr * 64 + cc * 2; return st * 1024 + (ob ^ (((ob >> 9) & 1) << 5)); }
__host__ __device__ __forceinline__ void stage_rc(int b, int& R, int& C) { const int st = b / 1024, sb = b % 1024, swz = sb ^ (((sb >> 9) & 1) << 5); R = (st >> 1) * 16 + swz / 64; C = (st & 1) * 32 + (swz % 64) / 2; }
__host__ __device__ __forceinline__ int perm32(int rho) { const int n = rho >> 4, i = rho & 15; return 8 * (i >> 2) + 4 * n + (i & 3); }
struct Unit { int pm, pn, e; };
__device__ __forceinline__ bool static_next(int nM, int nN, int G, int c, int i, int& pm, int& pn, int WGM = pg8::WGM) {
    const int nwg = nM * nN; const long L = (long)i * G + c; if (L >= nwg) return false;
    int wgid = (int)L; { const int q = nwg / NXCD, r = nwg % NXCD, xcd = wgid % NXCD, off = wgid / NXCD; wgid = (xcd < r ? xcd * (q + 1) : r * (q + 1) + (xcd - r) * q) + off; }
    const int nig = WGM * nN, gid = wgid / nig, fm = gid * WGM, gsz = (nM - fm) < WGM ? (nM - fm) : WGM;
    pm = fm + ((wgid % nig) % gsz); pn = (wgid % nig) / gsz; return true;
}
template <class Epi, class Sched, bool GATHER>
__device__ __forceinline__ void gemm_phase(LAS unsigned char* lds, const Sched& S, const Epi& E) {
    const int tid = tidx(), wid = __builtin_amdgcn_readfirstlane(tid >> 6), lane = tid & 63, wr = wid >> 2, wc = wid & 3, fr = lane & 15, fq = lane >> 4;
    unsigned voffB[2], vA0[2], vA1[2], nvA0[2], nvA1[2]; int RA[2], CA[2];
    constexpr unsigned hstep = (unsigned)HALF * K * 2, kstep = BK * 2;
#pragma unroll
    for (int i = 0; i < 2; ++i) { int R, C; stage_rc(tid * 16 + i * 8192, R, C); const int Rb = (R & ~31) + perm32(R & 31);
        RA[i] = R; CA[i] = C * 2; vA0[i] = (unsigned)(R * K + C) * 2u; vA1[i] = vA0[i] + hstep; voffB[i] = (unsigned)(Rb * K + C) * 2u; }
    const unsigned ldsw = (unsigned)wid * 1024u;
    const int aoff = lds_byte(wr * 64 + fr, fq * 8), boff = lds_byte(wc * 32 + fr, fq * 8);
#define PG8_SA(b, h) (((b) * 2 + (h)) * HTB)
#define PG8_SB(b, h) ((4 + (b) * 2 + (h)) * HTB)
#define PG8_STAGE(bufoff, gbase, voff) do { _Pragma("unroll") for (int _i = 0; _i < 2; ++_i) \
        __builtin_amdgcn_global_load_lds((const unsigned*)((const char*)(gbase) + (voff)[_i]), (LAS unsigned*)(lds + (bufoff) + ldsw + _i * 8192), 16, 0, 0); } while (0)
#define PG8_LDA(dst, b, h) do { _Pragma("unroll") for (int m = 0; m < 4; ++m) _Pragma("unroll") for (int k = 0; k < 2; ++k) dst[m][k] = *(const LAS bf16x8*)(lds + PG8_SA(b, h) + aoff + m * 2048 + k * 1024); } while (0)
#define PG8_LDB(dst, b, h) do { _Pragma("unroll") for (int n = 0; n < 2; ++n) _Pragma("unroll") for (int k = 0; k < 2; ++k) dst[n][k] = *(const LAS bf16x8*)(lds + PG8_SB(b, h) + boff + n * 2048 + k * 1024); } while (0)
#define PG8_MMA(ai, bj, At, Bt) do { __builtin_amdgcn_s_setprio(1); _Pragma("unroll") for (int m = 0; m < 4; ++m) _Pragma("unroll") for (int n = 0; n < 2; ++n) _Pragma("unroll") for (int k = 0; k < 2; ++k) \
        acc[ai][bj][m][n] = __builtin_amdgcn_mfma_f32_16x16x32_bf16(Bt[n][k], At[m][k], acc[ai][bj][m][n], 0, 0, 0); __builtin_amdgcn_s_setprio(0); } while (0)
#define PG8_WAIT_V(n) asm volatile("s_waitcnt vmcnt(" #n ")" ::: "memory")
#define PG8_WAIT_L(n) asm volatile("s_waitcnt lgkmcnt(" #n ")" ::: "memory")
#define PG8_BAR __builtin_amdgcn_s_barrier()
#define PG8_SCHED __builtin_amdgcn_sched_barrier(0)
    Unit cur, nxt; int ui = 0;
    if (!S.next(0, cur)) return;
    f32x4 acc[2][2][4][2];
#pragma unroll
    for (int a = 0; a < 2; ++a)
#pragma unroll
        for (int b = 0; b < 2; ++b)
#pragma unroll
            for (int m = 0; m < 4; ++m)
#pragma unroll
                for (int n = 0; n < 2; ++n) acc[a][b][m][n] = (f32x4){0.f, 0.f, 0.f, 0.f};
    bf16x8 At[4][2], B0[2][2], B1[2][2];
    const char* cA = S.a_ptr(cur); const char* cB = S.b_ptr(cur);
    if constexpr (GATHER) { S.voff(0, RA, CA, vA0, vA1); }
    PG8_STAGE(PG8_SB(0, 0), cB, voffB); PG8_STAGE(PG8_SB(0, 1), cB + hstep, voffB); PG8_STAGE(PG8_SA(0, 0), cA, vA0); PG8_STAGE(PG8_SA(0, 1), cA, vA1);
    if (wr == 1) PG8_BAR;
    PG8_WAIT_V(2); PG8_BAR;
    PG8_STAGE(PG8_SB(1, 0), cB + kstep, voffB); PG8_STAGE(PG8_SA(1, 0), cA + kstep, vA0); PG8_STAGE(PG8_SB(1, 1), cB + hstep + kstep, voffB);
    PG8_WAIT_V(6); PG8_BAR;
    for (;;) {
        const bool has_next = S.next(ui + 1, nxt);
        const char* nA = has_next ? S.a_ptr(nxt) : cA; const char* nB = has_next ? S.b_ptr(nxt) : cB;
#pragma unroll
        for (int i = 0; i < 2; ++i) { nvA0[i] = vA0[i]; nvA1[i] = vA1[i]; }
        if constexpr (GATHER) { if (has_next) S.voff(ui + 1, RA, CA, nvA0, nvA1); }
#pragma unroll 1
        for (int t = 0; t < NT; t += 2) {
            const bool last = (t == NT - 2);
            const char* a1 = cA + (size_t)(t + 1) * kstep;
            const char* a2 = last ? nA : cA + (size_t)(t + 2) * kstep; const char* b2 = last ? nB : cB + (size_t)(t + 2) * kstep;
            const char* a3 = a2 + kstep; const char* b3 = b2 + kstep;
            unsigned w0[2], w1[2];
#pragma unroll
            for (int i = 0; i < 2; ++i) { w0[i] = (GATHER && last) ? nvA0[i] : vA0[i]; w1[i] = (GATHER && last) ? nvA1[i] : vA1[i]; }
            PG8_LDB(B0, 0, 0); PG8_LDB(B1, 0, 1); PG8_SCHED; PG8_LDA(At, 0, 0); PG8_STAGE(PG8_SA(1, 1), a1, vA1);
            PG8_WAIT_V(8); PG8_WAIT_L(0); PG8_BAR; PG8_MMA(0, 0, At, B0); PG8_MMA(0, 1, At, B1); PG8_BAR; PG8_SCHED;
            PG8_LDA(At, 0, 1); PG8_STAGE(PG8_SB(0, 0), b2, voffB); PG8_STAGE(PG8_SB(0, 1), b2 + hstep, voffB); PG8_STAGE(PG8_SA(0, 0), a2, w0);
            PG8_WAIT_V(8); PG8_WAIT_L(0); PG8_BAR; PG8_MMA(1, 0, At, B0); PG8_MMA(1, 1, At, B1); PG8_BAR; PG8_SCHED;
            PG8_LDB(B0, 1, 0); PG8_LDB(B1, 1, 1); PG8_SCHED; PG8_LDA(At, 1, 0); PG8_STAGE(PG8_SA(0, 1), a2, w1);
            PG8_WAIT_V(8); PG8_WAIT_L(0); PG8_BAR; PG8_MMA(0, 0, At, B0); PG8_MMA(0, 1, At, B1); PG8_BAR; PG8_SCHED;
            PG8_LDA(At, 1, 1); PG8_STAGE(PG8_SB(1, 0), b3, voffB); PG8_STAGE(PG8_SB(1, 1), b3 + hstep, voffB); PG8_STAGE(PG8_SA(1, 0), a3, w0);
            PG8_WAIT_V(8); PG8_WAIT_L(0); PG8_BAR; PG8_MMA(1, 0, At, B0); PG8_MMA(1, 1, At, B1); PG8_BAR; PG8_SCHED;
        }
        if (wr == 0) PG8_BAR;
        E(acc, cur, ui, wr, wc, fr, fq);
        if (!has_next) break;
#pragma unroll
        for (int a = 0; a < 2; ++a)
#pragma unroll
            for (int b = 0; b < 2; ++b)
#pragma unroll
                for (int m = 0; m < 4; ++m)
#pragma unroll
                    for (int n = 0; n < 2; ++n) acc[a][b][m][n] = (f32x4){0.f, 0.f, 0.f, 0.f};
        cur = nxt; cA = nA; cB = nB; ++ui;
#pragma unroll
        for (int i = 0; i < 2; ++i) { vA0[i] = nvA0[i]; vA1[i] = nvA1[i]; }
        if (wr == 1) PG8_BAR;
    }
    PG8_WAIT_V(0);
    PG8_BAR;
#undef PG8_SA
#undef PG8_SB
#undef PG8_STAGE
#undef PG8_LDA
#undef PG8_LDB
#undef PG8_MMA
#undef PG8_WAIT_V
#undef PG8_WAIT_L
#undef PG8_BAR
#undef PG8_SCHED
}
typedef int v8i __attribute__((ext_vector_type(8)));
template <class Epi, class Sched, bool GATHER>
__device__ __forceinline__ void gemm_phase8(LAS unsigned char* lds, const Sched& S, const Epi& E) {
    const int tid = tidx(), wid = __builtin_amdgcn_readfirstlane(tid >> 6), lane = tid & 63, wr = wid >> 2, wc = wid & 3, fr = lane & 15, fq = lane >> 4;
    unsigned voffB[2], vA0[2], vA1[2], nvA0[2], nvA1[2]; int RA[2], CA[2];
    constexpr int ROWB = 1024, NT8 = ROWB / 128;
    constexpr unsigned hstep = (unsigned)HALF * ROWB, kstep = 128;
#pragma unroll
    for (int i = 0; i < 2; ++i) { int R, C; stage_rc(tid * 16 + i * 8192, R, C); const int Rb = (R & ~31) + perm32(R & 31);
        RA[i] = R; CA[i] = C * 2; vA0[i] = (unsigned)(R * ROWB + C * 2); vA1[i] = vA0[i] + hstep; voffB[i] = (unsigned)(Rb * ROWB + C * 2); }
    const unsigned ldsw = (unsigned)wid * 1024u;
    const int aoff = lds_byte(wr * 64 + fr, fq * 8), boff = lds_byte(wc * 32 + fr, fq * 8);
#define PG8_SA(b, h) (((b) * 2 + (h)) * HTB)
#define PG8_SB(b, h) ((4 + (b) * 2 + (h)) * HTB)
#define PG8_STAGE(bufoff, gbase, voff) do { _Pragma("unroll") for (int _i = 0; _i < 2; ++_i) \
        __builtin_amdgcn_global_load_lds((const unsigned*)((const char*)(gbase) + (voff)[_i]), (LAS unsigned*)(lds + (bufoff) + ldsw + _i * 8192), 16, 0, 0); } while (0)
#define PG8_LDA(dst, b, h) do { _Pragma("unroll") for (int m = 0; m < 4; ++m) { const u32x4 lo_ = *(const LAS u32x4*)(lds + PG8_SA(b, h) + aoff + m * 2048), hi_ = *(const LAS u32x4*)(lds + PG8_SA(b, h) + aoff + m * 2048 + 1024); dst[m] = (v8i){(int)lo_.x, (int)lo_.y, (int)lo_.z, (int)lo_.w, (int)hi_.x, (int)hi_.y, (int)hi_.z, (int)hi_.w}; } } while (0)
#define PG8_LDB(dst, b, h) do { _Pragma("unroll") for (int n = 0; n < 2; ++n) { const u32x4 lo_ = *(const LAS u32x4*)(lds + PG8_SB(b, h) + boff + n * 2048), hi_ = *(const LAS u32x4*)(lds + PG8_SB(b, h) + boff + n * 2048 + 1024); dst[n] = (v8i){(int)lo_.x, (int)lo_.y, (int)lo_.z, (int)lo_.w, (int)hi_.x, (int)hi_.y, (int)hi_.z, (int)hi_.w}; } } while (0)
#define PG8_MMA(ai, bj, At, Bt) do { __builtin_amdgcn_s_setprio(1); _Pragma("unroll") for (int m = 0; m < 4; ++m) _Pragma("unroll") for (int n = 0; n < 2; ++n) \
        asm volatile("v_mfma_f32_16x16x128_f8f6f4 %0, %1, %2, %0" : "+v"(acc[ai][bj][m][n]) : "v"(Bt[n]), "v"(At[m])); __builtin_amdgcn_s_setprio(0); } while (0)
#define PG8_MMAZ(ai, bj, At, Bt) do { __builtin_amdgcn_s_setprio(1); _Pragma("unroll") for (int m = 0; m < 4; ++m) _Pragma("unroll") for (int n = 0; n < 2; ++n) \
        asm volatile("v_mfma_f32_16x16x128_f8f6f4 %0, %1, %2, 0" : "=&v"(acc[ai][bj][m][n]) : "v"(Bt[n]), "v"(At[m])); __builtin_amdgcn_s_setprio(0); } while (0)
#define PG8_WAIT_V(n) asm volatile("s_waitcnt vmcnt(" #n ")" ::: "memory")
#define PG8_WAIT_L(n) asm volatile("s_waitcnt lgkmcnt(" #n ")" ::: "memory")
#define PG8_BAR __builtin_amdgcn_s_barrier()
#define PG8_SCHED __builtin_amdgcn_sched_barrier(0)
    Unit cur, nxt; int ui = 0;
    if (!S.next(0, cur)) return;
    f32x4 acc[2][2][4][2];
    v8i At[4], B0[2], B1[2];
    const char* cA = S.a_ptr(cur); const char* cB = S.b_ptr(cur);
    if constexpr (GATHER) { S.voff(0, RA, CA, vA0, vA1); }
    PG8_STAGE(PG8_SB(0, 0), cB, voffB); PG8_STAGE(PG8_SB(0, 1), cB + hstep, voffB); PG8_STAGE(PG8_SA(0, 0), cA, vA0); PG8_STAGE(PG8_SA(0, 1), cA, vA1);
    if (wr == 1) PG8_BAR;
    PG8_WAIT_V(2); PG8_BAR;
    PG8_STAGE(PG8_SB(1, 0), cB + kstep, voffB); PG8_STAGE(PG8_SA(1, 0), cA + kstep, vA0); PG8_STAGE(PG8_SB(1, 1), cB + hstep + kstep, voffB);
    PG8_WAIT_V(6); PG8_BAR;
    for (;;) {
        const bool has_next = S.next(ui + 1, nxt);
        const char* nA = has_next ? S.a_ptr(nxt) : cA; const char* nB = has_next ? S.b_ptr(nxt) : cB;
#pragma unroll
        for (int i = 0; i < 2; ++i) { nvA0[i] = vA0[i]; nvA1[i] = vA1[i]; }
        if constexpr (GATHER) { if (has_next) S.voff(ui + 1, RA, CA, nvA0, nvA1); }
#define PG8_KBODY(MZ) { \
            const bool last = (t == NT8 - 2); \
            const char* a1 = cA + (size_t)(t + 1) * kstep; \
            const char* a2 = last ? nA : cA + (size_t)(t + 2) * kstep; const char* b2 = last ? nB : cB + (size_t)(t + 2) * kstep; \
            const char* a3 = a2 + kstep; const char* b3 = b2 + kstep; \
            unsigned w0[2], w1[2]; \
            _Pragma("unroll") \
            for (int i = 0; i < 2; ++i) { w0[i] = (GATHER && last) ? nvA0[i] : vA0[i]; w1[i] = (GATHER && last) ? nvA1[i] : vA1[i]; } \
            PG8_LDB(B0, 0, 0); PG8_LDB(B1, 0, 1); PG8_SCHED; PG8_LDA(At, 0, 0); PG8_STAGE(PG8_SA(1, 1), a1, vA1); \
            PG8_WAIT_V(8); PG8_WAIT_L(0); PG8_BAR; MZ(0, 0, At, B0); MZ(0, 1, At, B1); PG8_BAR; PG8_SCHED; \
            PG8_LDA(At, 0, 1); PG8_STAGE(PG8_SB(0, 0), b2, voffB); PG8_STAGE(PG8_SB(0, 1), b2 + hstep, voffB); PG8_STAGE(PG8_SA(0, 0), a2, w0); \
            PG8_WAIT_V(8); PG8_WAIT_L(0); PG8_BAR; MZ(1, 0, At, B0); MZ(1, 1, At, B1); PG8_BAR; PG8_SCHED; \
            PG8_LDB(B0, 1, 0); PG8_LDB(B1, 1, 1); PG8_SCHED; PG8_LDA(At, 1, 0); PG8_STAGE(PG8_SA(0, 1), a2, w1); \
            PG8_WAIT_V(8); PG8_WAIT_L(0); PG8_BAR; PG8_MMA(0, 0, At, B0); PG8_MMA(0, 1, At, B1); PG8_BAR; PG8_SCHED; \
            PG8_LDA(At, 1, 1); PG8_STAGE(PG8_SB(1, 0), b3, voffB); PG8_STAGE(PG8_SB(1, 1), b3 + hstep, voffB); PG8_STAGE(PG8_SA(1, 0), a3, w0); \
            PG8_WAIT_V(8); PG8_WAIT_L(0); PG8_BAR; PG8_MMA(1, 0, At, B0); PG8_MMA(1, 1, At, B1); PG8_BAR; PG8_SCHED; \
        }
        { constexpr int t = 0; PG8_KBODY(PG8_MMAZ) }
#pragma unroll 1
        for (int t = 2; t < NT8; t += 2) PG8_KBODY(PG8_MMA)
#undef PG8_KBODY
        if (wr == 0) PG8_BAR;
        asm volatile("s_nop 15\n\ts_nop 15" ::: "memory");
        E(acc, cur, ui, wr, wc, fr, fq);
        if (!has_next) break;
        cur = nxt; cA = nA; cB = nB; ++ui;
#pragma unroll
        for (int i = 0; i < 2; ++i) { vA0[i] = nvA0[i]; vA1[i] = nvA1[i]; }
        if (wr == 1) PG8_BAR;
    }
    PG8_WAIT_V(0);
    PG8_BAR;
#undef PG8_SA
#undef PG8_SB
#undef PG8_STAGE
#undef PG8_LDA
#undef PG8_LDB
#undef PG8_MMA
#undef PG8_MMAZ
#undef PG8_WAIT_V
#undef PG8_WAIT_L
#undef PG8_BAR
#undef PG8_SCHED
}
struct DenseSched {
    const bf16* A; const bf16* Bt; int nM, nN, G, c; const LAS int* ul;
    __device__ __forceinline__ bool next(int i, Unit& u) const { if (i >= 18) return false; const int v = __builtin_amdgcn_readfirstlane(ul[i * 4]); if (v < 0) return false;
        u.e = 0; u.pm = __builtin_amdgcn_readfirstlane(ul[i * 4 + 1]); u.pn = __builtin_amdgcn_readfirstlane(ul[i * 4 + 2]); return true; }
    __device__ __forceinline__ const char* a_ptr(const Unit& u) const { return (const char*)A + (size_t)u.pm * (2u * HALF * K * 2); }
    __device__ __forceinline__ const char* b_ptr(const Unit& u) const { return (const char*)Bt + (size_t)u.pn * (2u * HALF * K * 2); }
    __device__ __forceinline__ void voff(int, const int (&)[2], const int (&)[2], unsigned (&)[2], unsigned (&)[2]) const {}
};
__device__ __forceinline__ u32x4 pair16(const u32x2 wa, const u32x2 wb) {
    const auto rx = __builtin_amdgcn_permlane16_swap(wa.x, wb.x, false, false); const auto ry = __builtin_amdgcn_permlane16_swap(wa.y, wb.y, false, false);
    u32x4 o; o.x = rx[0]; o.y = ry[0]; o.z = rx[1]; o.w = ry[1]; return o; }
struct EpiStore {
    bf16* O; int ldc; const LAS float* biasT; float scale;
    __device__ __forceinline__ void operator()(const f32x4 (&acc)[2][2][4][2], const Unit& u, int ui, int wr, int wc, int fr, int fq) const {
        const int row0 = u.pm * BM + wr * 64 + fr, col0 = u.pn * BM + wc * 32 + 8 * fq;
        f32x4 bv[2][2];
#pragma unroll
        for (int bj = 0; bj < 2; ++bj)
#pragma unroll
            for (int n = 0; n < 2; ++n) bv[bj][n] = *(const LAS f32x4*)(biasT + ui * 256 + bj * HALF + wc * 32 + 8 * fq + 4 * n);
#pragma unroll
        for (int ai = 0; ai < 2; ++ai)
#pragma unroll
            for (int m = 0; m < 4; ++m) { bf16* rowp = O + (size_t)(row0 + ai * HALF + m * 16) * ldc + col0;
#pragma unroll
                for (int bj = 0; bj < 2; ++bj) { const f32x4 v0 = acc[ai][bj][m][0] * scale + bv[bj][0], v1 = acc[ai][bj][m][1] * scale + bv[bj][1];
                    u32x4 w; w.x = pk2(v0[0], v0[1]); w.y = pk2(v0[2], v0[3]); w.z = pk2(v1[0], v1[1]); w.w = pk2(v1[2], v1[3]);
                    *(u32x4*)(rowp + bj * HALF) = w; } }
    }
};
struct EpiStoreRopeK {
    bf16* O; int ldc; const LAS float* biasT; const LAS f32x2* ropeT; float scale;
    __device__ __forceinline__ void operator()(const f32x4 (&acc)[2][2][4][2], const Unit& u, int ui, int wr, int wc, int fr, int fq) const {
        const int row0 = u.pm * BM + wr * 64 + fr, col0 = u.pn * BM + wc * 32 + 8 * fq; const bool rk = u.pn == 4 && u.pm < ML / BM;
        const int axis = wc & 1, f0 = 8 * (fq & 1); const float sg = (fq >> 1) ? 1.f : -1.f; const int l32_ = lane_op();
        f32x4 bv[2][2];
#pragma unroll
        for (int bj = 0; bj < 2; ++bj)
#pragma unroll
            for (int n = 0; n < 2; ++n) bv[bj][n] = *(const LAS f32x4*)(biasT + ui * 256 + bj * HALF + wc * 32 + 8 * fq + 4 * n);
#pragma unroll
        for (int ai = 0; ai < 2; ++ai)
#pragma unroll
            for (int m = 0; m < 4; ++m) { const int row = row0 + ai * HALF + m * 16; bf16* rowp = O + (size_t)row * ldc + col0;
                f32x4 cs[4];
                if (rk) { const int t = row & 4095, pos = axis ? (t & 63) : (t >> 6); const LAS f32x4* cp = (const LAS f32x4*)(ropeT + pos * 16 + f0);
#pragma unroll
                    for (int q = 0; q < 4; ++q) cs[q] = cp[q]; }
#pragma unroll
                for (int bj = 0; bj < 2; ++bj) { f32x4 v0 = acc[ai][bj][m][0] * scale + bv[bj][0], v1 = acc[ai][bj][m][1] * scale + bv[bj][1];
                    if (rk) {
#pragma unroll
                        for (int j = 0; j < 4; ++j) { const float p0 = shx(v0[j], 32, l32_), p1 = shx(v1[j], 32, l32_);
                            const float c0 = (j & 1) ? cs[j >> 1].z : cs[j >> 1].x, s0 = (j & 1) ? cs[j >> 1].w : cs[j >> 1].y, c1 = (j & 1) ? cs[2 + (j >> 1)].z : cs[2 + (j >> 1)].x, s1 = (j & 1) ? cs[2 + (j >> 1)].w : cs[2 + (j >> 1)].y;
                            v0[j] = v0[j] * c0 + sg * p0 * s0; v1[j] = v1[j] * c1 + sg * p1 * s1; } }
                    u32x4 w; w.x = pk2(v0[0], v0[1]); w.y = pk2(v0[2], v0[3]); w.z = pk2(v1[0], v1[1]); w.w = pk2(v1[2], v1[3]);
                    *(u32x4*)(rowp + bj * HALF) = w; } }
    }
};
struct EpiStore8 {
    unsigned char* O; int ldc; const LAS float* biasT; float scale, oscale;
    __device__ __forceinline__ void operator()(const f32x4 (&acc)[2][2][4][2], const Unit& u, int ui, int wr, int wc, int fr, int fq) const {
        const int row0 = u.pm * BM + wr * 64 + fr, col0 = u.pn * BM + wc * 32 + 8 * fq; const float so = scale * oscale;
        f32x4 bv[2][2];
#pragma unroll
        for (int bj = 0; bj < 2; ++bj)
#pragma unroll
            for (int n = 0; n < 2; ++n) bv[bj][n] = *(const LAS f32x4*)(biasT + ui * 256 + bj * HALF + wc * 32 + 8 * fq + 4 * n) * oscale;
#pragma unroll
        for (int ai = 0; ai < 2; ++ai)
#pragma unroll
            for (int mp = 0; mp < 2; ++mp) { unsigned char* rowp = O + (size_t)(row0 + ai * HALF + (2 * mp + (fq & 1)) * 16) * ldc + (col0 - 8 * (fq & 1));
#pragma unroll
                for (int bj = 0; bj < 2; ++bj) { u32x2 w[2];
#pragma unroll
                    for (int h = 0; h < 2; ++h) { const f32x4 v0 = acc[ai][bj][2 * mp + h][0] * so + bv[bj][0], v1 = acc[ai][bj][2 * mp + h][1] * so + bv[bj][1];
                        w[h].x = pk4_fp8(v0[0], v0[1], v0[2], v0[3]); w[h].y = pk4_fp8(v1[0], v1[1], v1[2], v1[3]); }
                    *(u32x4*)(rowp + bj * HALF) = pair16(w[0], w[1]); } }
    }
};
}

template <bool ROPEK, int MODE = 0> __device__ __forceinline__ void ph_gemm(const bf16* A, const bf16* Bt, const float* bias, bf16* O, int N, int nrows, LAS unsigned char* lds, const f32x2* ropeg = nullptr) {
    pg8::DenseSched S{A, Bt, nrows / 256, N / 256, (int)gridDim.x, (int)blockIdx.x, (const LAS int*)(lds + LDS_CTL + LC_UINFO)};
    LAS float* biasT = (LAS float*)(lds + LDS_CTL + LC_BIAS);
    if constexpr (MODE != 2) { const int TX = tidx(); LAS int* ui_ = (LAS int*)(lds + LDS_CTL + LC_UINFO);
      if (TX < 18) { int pm, pn; const bool ok = pg8::static_next(S.nM, S.nN, S.G, S.c, TX, pm, pn); ui_[TX * 4] = ok ? 0 : -1; ui_[TX * 4 + 1] = pm; ui_[TX * 4 + 2] = pn; }
      __syncthreads();
#pragma unroll
      for (int it = 0; it < 9; ++it) { const int j = TX + it * NTHR, i = j >> 8; if (ui_[i * 4] >= 0) biasT[j] = bias ? bias[ui_[i * 4 + 2] * 256 + (j & 255)] : 0.f; }
      if constexpr (ROPEK) { LAS f32x2* ropeT = (LAS f32x2*)(lds + LDS_CTL + LC_TOKT); for (int i = TX; i < 1024; i += NTHR) ropeT[i] = ropeg[i]; } }
    if constexpr (MODE != 1) {
    __syncthreads();
    if constexpr (ROPEK) { pg8::EpiStoreRopeK E{O, N, biasT, (LAS f32x2*)(lds + LDS_CTL + LC_TOKT), 1.f};
        pg8::gemm_phase<pg8::EpiStoreRopeK, pg8::DenseSched, false>(lds, S, E);
    } else { pg8::EpiStore E{O, N, biasT, 1.f};
        pg8::gemm_phase<pg8::EpiStore, pg8::DenseSched, false>(lds, S, E); }
    __syncthreads(); }
}

__device__ __forceinline__ void moe_tiles_init(const Ptrs& p, int layer, LAS int* cntc, LAS int* tile0) {
    const int TX = tidx();
    const unsigned* cnt = P_CTL(p) + CW_CNT + layer * 64;
    if (TX < 32) {
        const int cn = (int)__hip_atomic_load(cnt + TX, __ATOMIC_RELAXED, __HIP_MEMORY_SCOPE_AGENT), nt = (cn + TM - 1) / TM; int incl = nt;
#pragma unroll
        for (int o = 1; o < 32; o <<= 1) { const int t = __builtin_amdgcn_ds_bpermute(((TX - o) & 63) << 2, incl); if (TX >= o) incl += t; }
        cntc[TX] = cn; tile0[TX] = incl - nt; if (TX == 31) tile0[32] = incl; }
    __syncthreads();
}
__device__ __forceinline__ int moe_find(const LAS int* tile0, int t) { int e = 0;
#pragma unroll
    for (int x = 1; x < 32; ++x) e = tile0[x] <= t ? x : e;
    return e; }

namespace pg8 {
struct MoeSched {
    const char* A; const char* Bt; const LAS int* tile0; const LAS unsigned short* tokt; int nN, G, c; bool gather; int rowb; const LAS int* ul;
    __device__ __forceinline__ bool next(int i, Unit& u) const { if (i >= 18) return false; const int e = __builtin_amdgcn_readfirstlane(ul[i * 4]); if (e < 0) return false;
        u.e = e; u.pm = __builtin_amdgcn_readfirstlane(ul[i * 4 + 1]); u.pn = __builtin_amdgcn_readfirstlane(ul[i * 4 + 2]); return true; }
    __device__ __forceinline__ const char* a_ptr(const Unit& u) const { return gather ? A : A + (size_t)u.pm * (size_t)(BM * rowb); }
    __device__ __forceinline__ const char* b_ptr(const Unit& u) const { return Bt + ((size_t)u.e * nN + u.pn) * (size_t)(BM * rowb); }
    __device__ __forceinline__ void voff(int i, const int (&R)[2], const int (&C)[2], unsigned (&v0)[2], unsigned (&v1)[2]) const {
        const LAS unsigned short* tk = tokt + i * 256 + R[0];
#pragma unroll
        for (int k = 0; k < 2; ++k) { v0[k] = (unsigned)tk[64 * k] * (unsigned)rowb + (unsigned)C[0]; v1[k] = (unsigned)tk[128 + 64 * k] * (unsigned)rowb + (unsigned)C[0]; } }
};
struct EpiSwiglu {
    unsigned char* ACT; const LAS float* biasT;
    __device__ __forceinline__ void operator()(const f32x4 (&acc)[2][2][4][2], const Unit& u, int ui, int wr, int wc, int fr, int fq) const {
        const int row0 = u.pm * BM + wr * 64 + fr, ff0 = u.pn * HALF + wc * 32 + 8 * fq; const LAS float* bg = biasT + ui * 256 + wc * 32 + 8 * fq;
        f32x4 bgv[2], buv[2]; f32x2 kc, one; asm volatile("v_mov_b32 %0, 0xc01d265f\n\tv_mov_b32 %1, 0xc01d265f\n\tv_mov_b32 %2, 1.0\n\tv_mov_b32 %3, 1.0" : "=v"(kc.x), "=v"(kc.y), "=v"(one.x), "=v"(one.y));
#pragma unroll
        for (int n = 0; n < 2; ++n) { bgv[n] = *(const LAS f32x4*)(bg + 4 * n); buv[n] = *(const LAS f32x4*)(bg + HALF + 4 * n); }
#pragma unroll
        for (int ai = 0; ai < 2; ++ai)
#pragma unroll
            for (int mp = 0; mp < 2; ++mp) { u32x2 wq[2];
#pragma unroll
            for (int mh = 0; mh < 2; ++mh) { const int m = 2 * mp + mh; float a[8];
#pragma unroll
                for (int n = 0; n < 2; ++n) { const f32x4 g4 = acc[ai][0][m][n] * 0.03125f + bgv[n], u4 = acc[ai][1][m][n] * 0.03125f + buv[n];
#pragma unroll
                    for (int jp = 0; jp < 2; ++jp) {
                        const f32x2 gt = {fminf(g4[2 * jp], 7.f), fminf(g4[2 * jp + 1], 7.f)}, up1 = {fminf(fmaxf(u4[2 * jp], -6.f), 8.f), fminf(fmaxf(u4[2 * jp + 1], -6.f), 8.f)};
                        const f32x2 x = gt * kc; f32x2 e = {__builtin_amdgcn_exp2f(x.x), __builtin_amdgcn_exp2f(x.y)}; e = e + one;
                        const f32x2 r = {__builtin_amdgcn_rcpf(e.x), __builtin_amdgcn_rcpf(e.y)}, o = (up1 * gt) * r;
                        a[4 * n + 2 * jp] = o.x; a[4 * n + 2 * jp + 1] = o.y; } }
                wq[mh].x = pk4_fp8(a[0], a[1], a[2], a[3]); wq[mh].y = pk4_fp8(a[4], a[5], a[6], a[7]); }
                *(u32x4*)(ACT + (size_t)(row0 + ai * HALF + (2 * mp + (fq & 1)) * 16) * DFF + (ff0 - 8 * (fq & 1))) = pair16(wq[0], wq[1]); }
    }
};
}
__device__ __forceinline__ void ph_moe_up(const Ptrs& p, int layer, LAS unsigned char* lds) {
    const int TX = tidx();
    LAS int* cntc = (LAS int*)(lds + LDS_CTL + LC_CNT); LAS int* tile0 = (LAS int*)(lds + LDS_CTL + LC_TILE0); LAS unsigned short* tokt = (LAS unsigned short*)(lds + LDS_CTL + LC_TOKT);
    moe_tiles_init(p, layer, cntc, tile0);
    pg8::MoeSched S{(const char*)P_H8(p), (const char*)(P_WGU8(p) + (size_t)layer * NE * 2 * DFF * D), tile0, tokt, 8, (int)gridDim.x, (int)blockIdx.x, true, 1024, (const LAS int*)(lds + LDS_CTL + LC_UINFO)};
    LAS float* biasT = (LAS float*)(lds + LDS_CTL + LC_BIAS); const float* bgu = p.in[24] + (size_t)layer * NE * 2 * DFF;
    { LAS int* ui_ = (LAS int*)(lds + LDS_CTL + LC_UINFO);
      if (TX < 18) { int pm, pn; const bool ok = pg8::static_next(tile0[32], 8, S.G, S.c, TX, pm, pn, 2);     ui_[TX * 4] = ok ? moe_find(tile0, pm) : -1; ui_[TX * 4 + 1] = pm; ui_[TX * 4 + 2] = pn; }
      __syncthreads();
#pragma unroll
      for (int it = 0; it < 9; ++it) { const int j = TX + it * NTHR, i = j >> 8, sl = j & 255, e = ui_[i * 4];
          if (e >= 0) { const int pm = ui_[i * 4 + 1], pn = ui_[i * 4 + 2], idx = (pm - tile0[e]) * TM + sl;
              tokt[j] = (unsigned short)(idx < cntc[e] ? P_TOKL(p)[(size_t)e * CAP + idx] : 0);
              biasT[j] = bgu[(size_t)e * 2 * DFF + (sl >> 7) * DFF + pn * 128 + (sl & 127)] + (sl >= 128 ? 1.f : 0.f); } } }
    __syncthreads();
    pg8::EpiSwiglu E{P_ACT8(p), biasT};
    pg8::gemm_phase8<pg8::EpiSwiglu, pg8::MoeSched, true>(lds, S, E);
    __syncthreads();
}
template <int MODE> __device__ __forceinline__ void ph_moe_down(const Ptrs& p, int layer, LAS unsigned char* lds) {
    LAS int* tile0 = (LAS int*)(lds + LDS_CTL + LC_TILE0);
    pg8::MoeSched S{(const char*)P_ACT8(p), (const char*)(P_WDN8(p) + (size_t)layer * NE * DFF * D), tile0, nullptr, 4, (int)gridDim.x, (int)blockIdx.x, false, 1024, (const LAS int*)(lds + LDS_CTL + LC_UINFO)};
    LAS float* biasT = (LAS float*)(lds + LDS_CTL + LC_BIAS); const float* bd = p.in[26] + (size_t)layer * NE * D;
    if constexpr (MODE != 2) { const int TX = tidx(); LAS int* ui_ = (LAS int*)(lds + LDS_CTL + LC_UINFO);
      if (TX < 18) { int pm, pn; const bool ok = pg8::static_next(tile0[32], 4, S.G, S.c, TX, pm, pn, 32); ui_[TX * 4] = ok ? moe_find(tile0, pm) : -1; ui_[TX * 4 + 1] = pm; ui_[TX * 4 + 2] = pn; }
      __syncthreads();
#pragma unroll
      for (int it = 0; it < 9; ++it) { const int j = TX + it * NTHR, i = j >> 8, e = ui_[i * 4]; if (e >= 0) biasT[j] = bd[(size_t)e * D + ui_[i * 4 + 2] * 256 + (j & 255)]; } }
    if constexpr (MODE != 1) {
    __syncthreads();
    pg8::EpiStore8 E{P_OUTE8(p), D, biasT, 0.015625f, 4.f};
    pg8::gemm_phase8<pg8::EpiStore8, pg8::MoeSched, false>(lds, S, E);
    __syncthreads(); }
}

template <bool ROPEK, int MODE> __device__ __forceinline__ void ph_gemm8(const unsigned char* A8, const unsigned char* Bt8, const float* bias, bf16* O, int N, int nrows, LAS unsigned char* lds, float scale, const f32x2* ropeg = nullptr) {
    pg8::MoeSched S{(const char*)A8, (const char*)Bt8, nullptr, nullptr, N / 256, (int)gridDim.x, (int)blockIdx.x, false, 1024, (const LAS int*)(lds + LDS_CTL + LC_UINFO)};
    LAS float* biasT = (LAS float*)(lds + LDS_CTL + LC_BIAS);
    if constexpr (MODE != 2) { const int TX = tidx(); LAS int* ui_ = (LAS int*)(lds + LDS_CTL + LC_UINFO);
      if (TX < 18) { int pm, pn; const bool ok = pg8::static_next(nrows / 256, N / 256, S.G, S.c, TX, pm, pn); ui_[TX * 4] = ok ? 0 : -1; ui_[TX * 4 + 1] = pm; ui_[TX * 4 + 2] = pn; }
      __syncthreads();
#pragma unroll
      for (int it = 0; it < 9; ++it) { const int j = TX + it * NTHR, i = j >> 8; if (ui_[i * 4] >= 0) biasT[j] = bias ? bias[ui_[i * 4 + 2] * 256 + (j & 255)] : 0.f; }
      if constexpr (ROPEK) { LAS f32x2* ropeT = (LAS f32x2*)(lds + LDS_CTL + LC_TOKT); for (int i = TX; i < 1024; i += NTHR) ropeT[i] = ropeg[i]; } }
    if constexpr (MODE != 1) {
    __syncthreads();
    if constexpr (ROPEK) { pg8::EpiStoreRopeK E{O, N, biasT, (LAS f32x2*)(lds + LDS_CTL + LC_TOKT), scale};
        pg8::gemm_phase8<pg8::EpiStoreRopeK, pg8::MoeSched, false>(lds, S, E);
    } else { pg8::EpiStore E{O, N, biasT, scale};
        pg8::gemm_phase8<pg8::EpiStore, pg8::MoeSched, false>(lds, S, E); }
    __syncthreads(); }
}

namespace attn_body {
using bf16=__hip_bfloat16;
using bf16x8=__attribute__((ext_vector_type(8)))short;
using s16x4=__attribute__((ext_vector_type(4)))short;
using f32x16=__attribute__((ext_vector_type(16)))float;
using u32x4=__attribute__((ext_vector_type(4)))unsigned;
constexpr int D=64,DM=1024,PQ=1536,NZT=4;
constexpr int NW=8,QBLK=32,QB=QBLK*NW,KVBLK=64;
__device__ __forceinline__ int crow(int r,int hi){return (r&3)+8*(r>>2)+4*hi;}
#define SBAR() __builtin_amdgcn_sched_barrier(0)
__device__ __forceinline__ void wmask(f32x16&p0,f32x16&p1,int drel,int hi){
  const float NEG=-INFINITY; const int kb=drel+4*hi;
  #pragma unroll
  for(int r=0;r<16;++r){const int d=kb+(r&3)+8*(r>>2); if(d>128||d<-128)p0[r]=NEG; if(d+32>128||d+32<-128)p1[r]=NEG;}
}

constexpr int NSLOT=3, SLOTB=8192;
constexpr int LDS_K=0, LDS_V=NSLOT*SLOTB, LDS_WS=2*NSLOT*SLOTB, LDS_OST=LDS_WS+NW*64*4, LDS_BYTES=LDS_OST+NW*4096;
constexpr float C2=0.125f*1.4426950408889634f;
__device__ __forceinline__ void glds16(const void*sbase,unsigned voff,unsigned lds_dst){unsigned keep;
  asm volatile("s_mov_b32 %0, m0\n\ts_mov_b32 m0, %3\n\ts_nop 0\n\tglobal_load_lds_dwordx4 %1, %2\n\ts_mov_b32 m0, %0":"=&s"(keep):"v"(voff),"s"(sbase),"s"(lds_dst):"memory");}
__device__ __forceinline__ float max3f(float a,float b,float c){float r;asm("v_max3_f32 %0, %1, %2, %3":"=v"(r):"v"(a),"v"(b),"v"(c));return r;}
__device__ __forceinline__ float max2f(float a,float b){float r;asm("v_max_f32_e32 %0, %1, %2":"=v"(r):"v"(a),"v"(b));return r;}
__device__ __forceinline__ float fadd_s(float a,float b){float r;asm("v_add_f32_e32 %0, %1, %2":"=v"(r):"v"(a),"v"(b));return r;}
__device__ __forceinline__ float fsub_s(float a,float b){float r;asm("v_sub_f32_e32 %0, %1, %2":"=v"(r):"v"(a),"v"(b));return r;}
typedef float f32x2_t __attribute__((ext_vector_type(2))); typedef __bf16 bf16x2_t __attribute__((ext_vector_type(2)));
__device__ __forceinline__ unsigned cvtpk_s(float lo,float hi){f32x2_t v={lo,hi};bf16x2_t b=__builtin_convertvector(v,bf16x2_t);return __builtin_bit_cast(unsigned,b);}
#define WAIT_BAR(N) asm volatile("s_waitcnt vmcnt(" #N ") lgkmcnt(0)\n\ts_barrier":::"memory")

__device__ __forceinline__ void qkt(f32x16&p0,f32x16&p1,const char*Kslot,const bf16x8*qr,const f32x16&negm,int r32,int hi){
  const char*kb=Kslot+hi*1024+r32*16;
  #pragma unroll
  for(int d0=0;d0<4;++d0){
    const bf16x8 b0=*reinterpret_cast<const bf16x8*>(kb+d0*2048);
    const bf16x8 b1=*reinterpret_cast<const bf16x8*>(kb+d0*2048+512);
    if(d0==0){p0=__builtin_amdgcn_mfma_f32_32x32x16_bf16(b0,qr[0],negm,0,0,0);p1=__builtin_amdgcn_mfma_f32_32x32x16_bf16(b1,qr[0],negm,0,0,0);}
    else{p0=__builtin_amdgcn_mfma_f32_32x32x16_bf16(b0,qr[d0],p0,0,0,0);p1=__builtin_amdgcn_mfma_f32_32x32x16_bf16(b1,qr[d0],p1,0,0,0);}}
}
typedef __attribute__((address_space(3))) const char* lds_cptr;
typedef short v4i16_t __attribute__((ext_vector_type(4)));
__device__ __forceinline__ void kload8(bf16x8*kf,lds_cptr kp){
  kf[0]=*(const __attribute__((address_space(3))) bf16x8*)(kp);      kf[1]=*(const __attribute__((address_space(3))) bf16x8*)(kp+512);
  kf[2]=*(const __attribute__((address_space(3))) bf16x8*)(kp+2048); kf[3]=*(const __attribute__((address_space(3))) bf16x8*)(kp+2560);
  kf[4]=*(const __attribute__((address_space(3))) bf16x8*)(kp+4096); kf[5]=*(const __attribute__((address_space(3))) bf16x8*)(kp+4608);
  kf[6]=*(const __attribute__((address_space(3))) bf16x8*)(kp+6144); kf[7]=*(const __attribute__((address_space(3))) bf16x8*)(kp+6656);
}
__device__ __forceinline__ void kload2(bf16x8*kf,lds_cptr kp,int j){ kf[2*j]=*(const __attribute__((address_space(3))) bf16x8*)(kp+j*2048); kf[2*j+1]=*(const __attribute__((address_space(3))) bf16x8*)(kp+j*2048+512); }
__device__ __forceinline__ s16x4 vtr(lds_cptr p){ return __builtin_bit_cast(s16x4,__builtin_amdgcn_ds_read_tr16_b64_v4i16((__attribute__((address_space(3))) v4i16_t*)p)); }
__device__ __forceinline__ float rowmax(const f32x16&p0,const f32x16&p1){
  float a=max3f(p0[0],p0[1],p1[0]),b=max3f(p0[2],p0[3],p1[1]);a=max3f(a,p1[2],p1[3]);
  #pragma unroll
  for(int r=4;r<16;r+=4){a=max3f(a,p0[r],p0[r+1]);b=max3f(b,p0[r+2],p0[r+3]);a=max3f(a,p1[r],p1[r+1]);b=max3f(b,p1[r+2],p1[r+3]);}
  const float m=max2f(a,b);
  auto rr=__builtin_amdgcn_permlane32_swap(__float_as_uint(m),__float_as_uint(m),false,false);
  return max2f(__uint_as_float(rr[0]),__uint_as_float(rr[1]));
}
__device__ __forceinline__ void pv(f32x16*o,int vb,bf16x8 pa0,bf16x8 pa1,bf16x8 pa2,bf16x8 pa3){
  #pragma unroll
  for(int d0=0;d0<2;++d0){s16x4 lo[4],hi[4];
    #pragma unroll
    for(int ks=0;ks<4;++ks){
      asm volatile("ds_read_b64_tr_b16 %0,%1 offset:%c2":"=&v"(lo[ks]):"v"(vb),"i"(d0*4096+ks*1024):"memory");
      asm volatile("ds_read_b64_tr_b16 %0,%1 offset:%c2":"=&v"(hi[ks]):"v"(vb),"i"(d0*4096+ks*1024+512):"memory");}
    asm volatile("s_waitcnt lgkmcnt(0)":::"memory");SBAR();
    #define PK(k) (bf16x8){lo[k][0],lo[k][1],lo[k][2],lo[k][3],hi[k][0],hi[k][1],hi[k][2],hi[k][3]}
    o[d0]=__builtin_amdgcn_mfma_f32_32x32x16_bf16(pa0,PK(0),o[d0],0,0,0);
    o[d0]=__builtin_amdgcn_mfma_f32_32x32x16_bf16(pa1,PK(1),o[d0],0,0,0);
    o[d0]=__builtin_amdgcn_mfma_f32_32x32x16_bf16(pa2,PK(2),o[d0],0,0,0);
    o[d0]=__builtin_amdgcn_mfma_f32_32x32x16_bf16(pa3,PK(3),o[d0],0,0,0);
    #undef PK
  }
}

#ifndef ATTN_STORE16
#define ATTN_STORE16(p,v) (*(u32x4*)(p)=(v))
#endif
template<int THRL,bool WIN,bool PAIR> __device__ __forceinline__ void attn_unit(int qrow0,int qpos0,int h,int zrow0,int lrow0,int lpos0,int NT,const float*sinkp,const float*qn,const float*ropet,bool rope,const bf16*__restrict__ QKV,unsigned char*O8,char*shm){
  const int tid=tidx(),lane=tid&63,r32=lane&31,hi=lane>>5; const int wid=__builtin_amdgcn_readfirstlane(tid>>6);
  const int qw=PAIR?(wid&3):wid, hh=PAIR?h+(wid>>2):h;
  const float sinkl2=WIN?sinkp[hh]*1.4426950408889634f:0.f;
  const bf16*Qw=QKV+(long)(qrow0+qw*QBLK)*PQ+hh*D;
  const bf16*Kh=QKV+1024+(h>>2)*D,*Vh=QKV+1280+(h>>2)*D;
  const unsigned lds0=(unsigned)(uintptr_t)shm;
  float*wsf=(float*)(shm+LDS_WS)+wid*64;
  const unsigned koff=(unsigned)(lane*PQ+wid*8)*2u;
  const unsigned voffv=(unsigned)((16*(wid&3)+(lane>>2))*PQ+(wid>>2)*32+(lane&3)*8)*2u;
  #define TROW(t) ((t)<NZT?zrow0+KVBLK*(t):lrow0+KVBLK*((t)-NZT))
  const unsigned kdst=lds0+LDS_K+wid*1024, vdst=lds0+LDS_V+wid*1024;
  #define DMA_K(t,slot) glds16(Kh+(long)TROW(t)*PQ,koff,(unsigned)__builtin_amdgcn_readfirstlane(kdst+(slot)))
  #define DMA_V(t,slot) glds16(Vh+(long)TROW(t)*PQ,voffv,(unsigned)__builtin_amdgcn_readfirstlane(vdst+(slot)))
  const int vb0=(int)(lds0+LDS_V)+((lane>>4)&1)*32+(lane&3)*8+(4*hi+((lane&15)>>2))*64;
  const char*Kbase=shm+LDS_K; bf16x8 kf[8];
  const lds_cptr shm3=(lds_cptr)shm; const lds_cptr kp0=shm3+LDS_K+hi*1024+r32*16; const lds_cptr vp0=shm3+LDS_V+((lane>>4)&1)*32+(lane&3)*8+(4*hi+((lane&15)>>2))*64;
  DMA_K(0,0);DMA_V(0,0);DMA_K(1,SLOTB);
  bf16x8 qr[4];
  #pragma unroll
  for(int d0=0;d0<4;++d0)qr[d0]=*reinterpret_cast<const bf16x8*>(&Qw[(long)r32*PQ+d0*16+hi*8]);
  { float q[4][8];
    #pragma unroll
    for(int d0=0;d0<4;++d0){
      #pragma unroll
      for(int j=0;j<8;++j)q[d0][j]=__uint_as_float(((unsigned)(unsigned short)qr[d0][j])<<16);}
    if(!WIN){ float ss=0.f;
      #pragma unroll
      for(int d0=0;d0<4;++d0){
        #pragma unroll
        for(int j=0;j<8;++j)ss+=q[d0][j]*q[d0][j];}
      ss+=::shx(ss,32,lane); const float rs=1.0f/sqrtf(ss*(1.f/64.f)+1e-6f);
      #pragma unroll
      for(int d0=0;d0<4;++d0){ const float4 g0=*reinterpret_cast<const float4*>(qn+16*d0+8*hi),g1=*reinterpret_cast<const float4*>(qn+16*d0+8*hi+4);
        q[d0][0]*=rs*g0.x;q[d0][1]*=rs*g0.y;q[d0][2]*=rs*g0.z;q[d0][3]*=rs*g0.w;q[d0][4]*=rs*g1.x;q[d0][5]*=rs*g1.y;q[d0][6]*=rs*g1.z;q[d0][7]*=rs*g1.w;} }
    if(rope){ const int t=qpos0+qw*QBLK+r32;
      #pragma unroll
      for(int a=0;a<2;++a){ const int pos=a?(t&63):(t>>6); const float4*cp=reinterpret_cast<const float4*>(ropet+(pos*16+8*hi)*2);
        #pragma unroll
        for(int jp=0;jp<4;++jp){ const float4 c=cp[jp];
          { const float x1=q[2*a][2*jp],x2=q[2*a+1][2*jp]; q[2*a][2*jp]=x1*c.x-x2*c.y; q[2*a+1][2*jp]=x2*c.x+x1*c.y; }
          { const float x1=q[2*a][2*jp+1],x2=q[2*a+1][2*jp+1]; q[2*a][2*jp+1]=x1*c.z-x2*c.w; q[2*a+1][2*jp+1]=x2*c.z+x1*c.w; } } } }
    #pragma unroll
    for(int d0=0;d0<4;++d0){ u32x4 w; w.x=cvtpk_s(q[d0][0]*C2,q[d0][1]*C2); w.y=cvtpk_s(q[d0][2]*C2,q[d0][3]*C2); w.z=cvtpk_s(q[d0][4]*C2,q[d0][5]*C2); w.w=cvtpk_s(q[d0][6]*C2,q[d0][7]*C2); qr[d0]=__builtin_bit_cast(bf16x8,w); } }
  float mhat=0.f,l_reg=0.f;f32x16 o[2],negm; { float z_=0.f; asm volatile("":"+v"(z_));
    _Pragma("unroll") for(int r=0;r<16;++r){o[0][r]=z_;o[1][r]=z_;negm[r]=z_;} } asm volatile("":"+v"(negm));
  const int qrel=wid*QBLK+r32;
  #define CMASK(P0,P1,t) do{ if(WIN&&(t)>=NZT){ const int dw_=lpos0+KVBLK*((t)-NZT)-(qpos0+qw*QBLK);     \
      if(dw_>159||dw_<-191){ float ni_=-INFINITY; asm volatile("":"+v"(ni_)); _Pragma("unroll") for(int r=0;r<16;++r){P0[r]=ni_;P1[r]=ni_;} }     \
      else if(dw_>64||dw_<-96){ int lm_=lane; asm volatile("":"+v"(lm_)); wmask(P0,P1,dw_-(lm_&31),lm_>>5); } } }while(0)
  bool resc=false;
  #define START(P0,P1) do{ const float rm=rowmax(P0,P1); resc=false; \
    { const float dl=rm; mhat=fadd_s(mhat,dl); \
      _Pragma("unroll") for(int r=0;r<16;++r){P0[r]=fsub_s(P0[r],dl);P1[r]=fsub_s(P1[r],dl);} \
      _Pragma("unroll") for(int r=0;r<16;++r)negm[r]=-mhat; asm volatile("":"+v"(negm)); } \
    _Pragma("unroll") for(int r=0;r<16;++r)P0[r]=__builtin_amdgcn_exp2f(P0[r]); }while(0)
  #define RESC() do{ if(resc){ asm volatile("s_waitcnt lgkmcnt(0)":::"memory"); \
      _Pragma("unroll") for(int d_=0;d_<2;++d_) _Pragma("unroll") for(int r=0;r<16;++r)o[d_][r]*=wsf[crow(r,hi)]; } }while(0)
  f32x16 pA0,pA1,pB0,pB1;
  int sl_prev=0,sl_cur=0,sl_next=SLOTB;
  #define ROT() do{sl_prev=sl_cur;sl_cur=sl_next;sl_next=(sl_next==(NSLOT-1)*SLOTB)?0:sl_next+SLOTB;}while(0)
  DMA_K(2,2*SLOTB);
  WAIT_BAR(3);
  qkt(pA0,pA1,Kbase,qr,negm,r32,hi);asm volatile("s_nop 15\n\ts_nop 7":"+v"(pA0),"+v"(pA1));CMASK(pA0,pA1,0);
  START(pA0,pA1);
  _Pragma("unroll") for(int r=0;r<16;++r)pA1[r]=__builtin_amdgcn_exp2f(pA1[r]);
  WAIT_BAR(0);
  DMA_K(3,0);DMA_V(1,SLOTB);
  ROT();
  kload8(kf,kp0+sl_cur);
  WAIT_BAR(2);
  s16x4 vlo[8],vhi[8]; u32x4 pw0,pw1,pw2,pw3;
  #define PKW(P,B) cvtpk_s(P[B],P[B+1])
  #define PAF(k) __builtin_bit_cast(bf16x8,pw##k)
  #define VFR(i) (bf16x8){vlo[i][0],vlo[i][1],vlo[i][2],vlo[i][3],vhi[i][0],vhi[i][1],vhi[i][2],vhi[i][3]}
  #define PIN(x) asm volatile("":"+v"(x))
  #define MX3(a,b,c) __builtin_fmaxf(__builtin_fmaxf((a),(b)),(c))
  #define GAPA(MF,A0,A1,A2,A3,W0,W1,PW) do{ MF; sacc+=A0; sacc+=A1; sacc+=A2; sacc+=A3; PIN(sacc); W0; W1; PIN(PW); SBAR(); }while(0)
  #define EX(v) __builtin_amdgcn_exp2f(v)
  #define GAPB(MF,X,B) do{ MF; X[B]=EX(X[B]); X[B+1]=EX(X[B+1]); X[B+2]=EX(X[B+2]); X[B+3]=EX(X[B+3]); PIN(X); SBAR(); }while(0)
  #define VRD(i) do{ vlo[i]=vtr(vp_+(((i)>>2)*4096+((i)&3)*1024)); vhi[i]=vtr(vp_+(((i)>>2)*4096+((i)&3)*1024+512)); }while(0)
  #define KRD(G,j) do{ if(G){ kload2(kf,kp0+sl_next,j); SBAR(); } }while(0)
  #define STEP(C0,C1,P0,P1,t,GK,GV,GL) do{ SBAR(); \
    const lds_cptr vp_=vp0+sl_prev; \
    VRD(0); SBAR(); float sacc=(P0[0]+P0[1]); \
    GAPA(C0=__builtin_amdgcn_mfma_f32_32x32x16_bf16(kf[0],qr[0],negm,0,0,0), P0[2],P0[3],P0[4],P0[5],     pw0[0]=PKW(P0,0), pw0[1]=PKW(P0,2), pw0); \
    VRD(4); SBAR(); GAPA(C1=__builtin_amdgcn_mfma_f32_32x32x16_bf16(kf[1],qr[0],negm,0,0,0), P0[6],P0[7],P0[8],P0[9],     pw0[2]=PKW(P0,4), pw0[3]=PKW(P0,6), pw0); \
    VRD(1); SBAR(); GAPA(C0=__builtin_amdgcn_mfma_f32_32x32x16_bf16(kf[2],qr[1],C0,0,0,0),   P0[10],P0[11],P0[12],P0[13], pw1[0]=PKW(P0,8), pw1[1]=PKW(P0,10), pw1); \
    VRD(5); SBAR(); GAPA(C1=__builtin_amdgcn_mfma_f32_32x32x16_bf16(kf[3],qr[1],C1,0,0,0),   P0[14],P0[15],P1[0],P1[1],   pw1[2]=PKW(P0,12),pw1[3]=PKW(P0,14), pw1); \
    VRD(2); SBAR(); GAPA(C0=__builtin_amdgcn_mfma_f32_32x32x16_bf16(kf[4],qr[2],C0,0,0,0),   P1[2],P1[3],P1[4],P1[5],     pw2[0]=PKW(P1,0), pw2[1]=PKW(P1,2), pw2); \
    VRD(6); SBAR(); GAPA(C1=__builtin_amdgcn_mfma_f32_32x32x16_bf16(kf[5],qr[2],C1,0,0,0),   P1[6],P1[7],P1[8],P1[9],     pw2[2]=PKW(P1,4), pw2[3]=PKW(P1,6), pw2); \
    VRD(3); SBAR(); GAPA(C0=__builtin_amdgcn_mfma_f32_32x32x16_bf16(kf[6],qr[3],C0,0,0,0),   P1[10],P1[11],P1[12],P1[13], pw3[0]=PKW(P1,8), pw3[1]=PKW(P1,10), pw3); \
    VRD(7); SBAR(); GAPA(C1=__builtin_amdgcn_mfma_f32_32x32x16_bf16(kf[7],qr[3],C1,0,0,0),   P1[14],P1[15],0.f,0.f,       pw3[2]=PKW(P1,12),pw3[3]=PKW(P1,14), pw3); \
    l_reg+=sacc; \
    if(GK){DMA_K((t)+3,sl_cur);} if(GV){DMA_V((t)+1,sl_next);} \
    CMASK(C0,C1,t); \
    { float a=MX3(C0[0],C0[1],C1[0]),b=MX3(C0[2],C0[3],C1[1]); a=MX3(a,C1[2],C1[3]); \
      _Pragma("unroll") for(int r=4;r<16;r+=4){a=MX3(a,C0[r],C0[r+1]);b=MX3(b,C0[r+2],C0[r+3]);a=MX3(a,C1[r],C1[r+1]);b=MX3(b,C1[r+2],C1[r+3]);} \
      float rm=__builtin_fmaxf(a,b); { auto rr=__builtin_amdgcn_permlane32_swap(__float_as_uint(rm),__float_as_uint(rm),false,false); rm=__builtin_fmaxf(__uint_as_float(rr[0]),__uint_as_float(rr[1])); } \
      resc=false; \
      if(__builtin_expect(__any(rm>(float)THRL),0)){ const float dl=__builtin_fmaxf(rm,0.f); mhat+=dl; \
        _Pragma("unroll") for(int r=0;r<16;++r){C0[r]-=dl;C1[r]-=dl;} \
        _Pragma("unroll") for(int r=0;r<16;++r)negm[r]=-mhat; asm volatile("":"+v"(negm)); \
        const float f=__builtin_amdgcn_exp2f(-dl); l_reg*=f; if(hi==0)wsf[r32]=f; resc=true; } } \
    SBAR(); \
    GAPB(o[0]=__builtin_amdgcn_mfma_f32_32x32x16_bf16(PAF(0),VFR(0),o[0],0,0,0), C0,0); \
    GAPB(o[1]=__builtin_amdgcn_mfma_f32_32x32x16_bf16(PAF(0),VFR(4),o[1],0,0,0), C0,4); \
    KRD(GL,0); GAPB(o[0]=__builtin_amdgcn_mfma_f32_32x32x16_bf16(PAF(1),VFR(1),o[0],0,0,0), C0,8); \
    KRD(GL,1); GAPB(o[1]=__builtin_amdgcn_mfma_f32_32x32x16_bf16(PAF(1),VFR(5),o[1],0,0,0), C0,12); \
    KRD(GL,2); GAPB(o[0]=__builtin_amdgcn_mfma_f32_32x32x16_bf16(PAF(2),VFR(2),o[0],0,0,0), C1,0); \
    KRD(GL,3); GAPB(o[1]=__builtin_amdgcn_mfma_f32_32x32x16_bf16(PAF(2),VFR(6),o[1],0,0,0), C1,4); \
    GAPB(o[0]=__builtin_amdgcn_mfma_f32_32x32x16_bf16(PAF(3),VFR(3),o[0],0,0,0), C1,8); \
    GAPB(o[1]=__builtin_amdgcn_mfma_f32_32x32x16_bf16(PAF(3),VFR(7),o[1],0,0,0), C1,12); \
    }while(0)
  int t=1;
  for(;t+5<NT;t+=2){
    STEP(pB0,pB1,pA0,pA1,t,true,true,true);     WAIT_BAR(2); RESC(); ROT();
    STEP(pA0,pA1,pB0,pB1,t+1,true,true,true);   WAIT_BAR(2); RESC(); ROT();
  }
  #define ENDW(tt) do{ if((tt)+3<NT){WAIT_BAR(2);} else if((tt)+2<NT){WAIT_BAR(1);} else {WAIT_BAR(0);} }while(0)
  for(;t+1<NT;t+=2){
    STEP(pB0,pB1,pA0,pA1,t,(t+3<NT),(t+1<NT),(t+1<NT));       ENDW(t);   RESC(); ROT();
    STEP(pA0,pA1,pB0,pB1,t+1,(t+4<NT),(t+2<NT),(t+2<NT));     ENDW(t+1); RESC(); ROT();
  }
  STEP(pB0,pB1,pA0,pA1,NT-1,false,false,false); RESC();
  { float sacc=pB0[0]+pB0[1]; _Pragma("unroll") for(int r=2;r<16;++r)sacc+=pB0[r]; _Pragma("unroll") for(int r=0;r<16;++r)sacc+=pB1[r]; l_reg+=sacc;
    pw0=(u32x4){PKW(pB0,0),PKW(pB0,2),PKW(pB0,4),PKW(pB0,6)};pw1=(u32x4){PKW(pB0,8),PKW(pB0,10),PKW(pB0,12),PKW(pB0,14)};pw2=(u32x4){PKW(pB1,0),PKW(pB1,2),PKW(pB1,4),PKW(pB1,6)};pw3=(u32x4){PKW(pB1,8),PKW(pB1,10),PKW(pB1,12),PKW(pB1,14)};
    SBAR(); pv(o,vb0+sl_cur,PAF(0),PAF(1),PAF(2),PAF(3)); }
  #undef PKW
  #undef PAF
  #undef VFR
  #undef PIN
  #undef MX3
  #undef GAPA
  #undef GAPB
  #undef EX
  #undef VRD
  #undef KRD
  #undef STEP
  #undef ENDW
  int lane_e=lane; asm volatile("":"+v"(lane_e)); const int r32e=lane_e&31,hie=lane_e>>5;
  {auto rr=__builtin_amdgcn_permlane32_swap(__float_as_uint(l_reg),__float_as_uint(l_reg),false,false);l_reg=__uint_as_float(rr[0])+__uint_as_float(rr[1]);}
  if(WIN)l_reg+=__builtin_amdgcn_exp2f(sinkl2-mhat);
  if(hie==0)wsf[32+r32e]=l_reg;asm volatile("s_waitcnt lgkmcnt(0)":::"memory");
  float rli[16];
  #pragma unroll
  for(int r=0;r<16;++r)rli[r]=__builtin_amdgcn_rcpf(wsf[32+crow(r,hie)]);
  unsigned char*Ow=O8+(long)(qrow0+qw*QBLK)*DM+hh*D;
  { bf16*stg=(bf16*)(shm+LDS_OST)+wid*2048;
    #pragma unroll
    for(int r=0;r<16;++r){const int orow=crow(r,hie);
      #pragma unroll
      for(int d0=0;d0<2;++d0)stg[orow*64+d0*32+r32e]=__float2bfloat16(o[d0][r]*rli[r]);}
    asm volatile("s_waitcnt lgkmcnt(0)":::"memory");
    #pragma unroll
    for(int i=0;i<2;++i){const int row=i*16+(lane_e>>2),ch=lane_e&3; const u32x4 va=*(const u32x4*)(stg+row*64+ch*16),vb=*(const u32x4*)(stg+row*64+ch*16+8);
      u32x4 w8;
      #define F8LO(x) fminf(fmaxf(__uint_as_float((x)<<16)*OSC_ATT,-448.f),448.f)
      #define F8HI(x) fminf(fmaxf(__uint_as_float((x)&0xffff0000u)*OSC_ATT,-448.f),448.f)
      w8.x=::pk4_fp8(F8LO(va.x),F8HI(va.x),F8LO(va.y),F8HI(va.y)); w8.y=::pk4_fp8(F8LO(va.z),F8HI(va.z),F8LO(va.w),F8HI(va.w));
      w8.z=::pk4_fp8(F8LO(vb.x),F8HI(vb.x),F8LO(vb.y),F8HI(vb.y)); w8.w=::pk4_fp8(F8LO(vb.z),F8HI(vb.z),F8LO(vb.w),F8HI(vb.w));
      #undef F8LO
      #undef F8HI
      ATTN_STORE16(Ow+(long)row*DM+ch*16,w8);} }
  asm volatile("s_waitcnt lgkmcnt(0)\n\ts_barrier":::"memory");
  #undef TROW
  #undef DMA_K
  #undef DMA_V
  #undef CMASK
  #undef START
  #undef RESC
  #undef ROT
}
constexpr int ATTN_LDS_BYTES=LDS_BYTES;
#undef SBAR
#undef WAIT_BAR
}

template <bool WIN> __device__ __forceinline__ void ph_attn(const Ptrs& p, const float* sink, const float* qn, bool need_ctx, char* shm) {
    const int G = gridDim.x, c = blockIdx.x, per = (2048 + G - 1) / G;
    const int cs = (G & 7) == 0 ? (c & 7) * (G >> 3) + (c >> 3) : c;
    const attn_body::bf16* qkv = (const attn_body::bf16*)P_BIG(p); unsigned char* o = P_O8(p);
    for (int u = cs * per; u < (cs + 1) * per && u < 2048; ++u) {
        if constexpr (WIN) {
            const int b = u >> 8, h = ((u >> 5) & 7) * 2, qb = u & 31;
            int lt0 = 2 * qb - 2; if (lt0 < 0) lt0 = 0; int lt1 = 2 * qb + 4; if (lt1 > 64) lt1 = 64;
            attn_body::attn_unit<8, true, true>(b * SEQ + qb * 128, qb * 128, h, ML + b * CL, b * SEQ + 64 * lt0, 64 * lt0, 4 + lt1 - lt0, sink, qn, (const float*)P_ROPE(p), true, qkv, o, shm);
        } else {
            const int b = u >> 8, h = (u >> 4) & 15, qb = u & 15;
            attn_body::attn_unit<8, false, false>(b * SEQ + qb * 256, qb * 256, h, ML + b * CL, b * SEQ, 0, 4 + 64, sink, qn, (const float*)P_ROPE(p), true, qkv, o, shm); }
    }
    if (need_ctx) for (int u = c; u < 128; u += G) {
        const int b = u >> 4, h = u & 15;
        attn_body::attn_unit<8, WIN, false>(ML + b * CL, 0, h, ML + b * CL, 0, 0, 4, sink, qn, (const float*)P_ROPE(p), false, qkv, o, shm);
    }
    __syncthreads();
}

struct Args { Ptrs p; int lo, hi; };
__global__ void __launch_bounds__(NTHR, 2) mk_fwd(Args a) {
    extern __shared__ __attribute__((aligned(16))) unsigned char lds_raw[];
    LAS unsigned char* lds = (LAS unsigned char*)lds_raw;
    typedef const __attribute__((address_space(4))) Args CArgs;
    CArgs* const ka = (CArgs*)__builtin_amdgcn_kernarg_segment_ptr();
    const Ptrs& p = a.p;
    for (int u = threadIdx.x; u < (LDS_BYTES - LDS_CTL) / 4; u += NTHR) ((LAS unsigned*)(lds + LDS_CTL))[u] = 0u;
    __syncthreads();
    if ((threadIdx.x & 63) == 0) *(LAS int*)(lds + LDS_CTL + LC_WTAB + 4 * hw_slot()) = (int)(threadIdx.x >> 6);
    __syncthreads();
    XcdBarrier bar = xcd_barrier_post(P_CTL(p) + CW_BAR, (volatile LAS unsigned*)(lds + LDS_CTL + LC_BAR));
#define LOADP CArgs* kq_ = ka; asm volatile("" : "+s"(kq_)); Ptrs p; _Pragma("unroll") for (int i_ = 0; i_ < 27; ++i_) p.in[i_] = kq_->p.in[i_]; p.out = kq_->p.out; p.ws = kq_->p.ws
#define PHN(BODY, NEXTPRO) do { { LOADP; BODY; } { const XbTicket tk_ = xcd_arrive(bar); { LOADP; NEXTPRO; } xcd_wait(bar, tk_); } } while (0)
#define NOPRO (void)0
#define GEMM1(MODE, LY) do { const int k_ = (LY) % 3, j_ = (LY) / 3; const int rq_ = (LY) < DEPTH - 1 ? M : ML; \
        const bf16* W1_ = P_WT(p) + (size_t)(k_ == 0 ? WT_WINQKV + j_ * QKVD : k_ == 1 ? WT_CONVIN : WT_FULLQKV) * D; const float* b1_ = k_ == 0 ? p.in[11] + (size_t)j_ * QKVD : nullptr; \
        const int N1_ = k_ == 1 ? 3072 : QKVD, rows1_ = k_ == 1 ? rq_ : M; \
        if (k_ == 0) { if (G1F8 & 1u) (ph_gemm8<true, MODE>(P_H8A(p), P_WQ8W(p, j_), b1_, P_BIG(p), N1_, rows1_, lds, 0.03125f, P_ROPE(p))); else (ph_gemm<true, MODE>(P_H(p), W1_, b1_, P_BIG(p), N1_, rows1_, lds, P_ROPE(p))); } \
        else if (k_ == 2 && (G1F8 & 4u)) (ph_gemm8<false, MODE>(P_H8A(p), P_WQ8F(p), nullptr, P_BIG(p), N1_, rows1_, lds, 0.03125f)); \
        else (ph_gemm<false, MODE>(P_H(p), W1_, b1_, P_BIG(p), N1_, rows1_, lds)); } while (0)
#define WO(MODE) (ph_gemm8<false, MODE>(P_O8(p), P_WO8(p) + (size_t)(kind == 0 ? j : kind == 1 ? 2 : 3) * D * D, nullptr, P_MX(p), D, rq, lds, kind == 1 ? 1.f / (64.f * OSC_CONV) : 1.f / (64.f * OSC_ATT)))
    LAS int* lcnt = (LAS int*)(lds + LDS_CTL + LC_LCNT); LAS int* lbase = (LAS int*)(lds + LDS_CTL + LC_LBASE); LAS int* pst = (LAS int*)(lds + LDS_CTL + LC_PST); LAS int* lasg = (LAS int*)(lds + LDS_CTL + LC_LASG);
    PHN(ph_weights(p, lds); ph_mod(p, lds), NOPRO);
    PHN(ph_input(p), GEMM1(1, 0));
    for (int layer = 0; layer < DEPTH; ++layer) {
        const int kind = layer % 3, j = layer / 3; const bool need_ctx = layer < DEPTH - 1; const int rq = need_ctx ? M : ML;
        PHN(GEMM1(2, layer), NOPRO);
        if (kind != 0) PHN(if (kind == 1) ph_conv(p, p.in[15] + (size_t)j * 3 * D, rq); else ph_kproc<2>(p, p.in[19] + j * 64), if (kind == 1) WO(1));
        if (kind != 1) PHN(if (kind == 0) ph_attn<true>(p, p.in[12] + j * 16, nullptr, need_ctx, (char*)lds_raw); else ph_attn<false>(p, nullptr, p.in[18] + j * 64, need_ctx, (char*)lds_raw), WO(1));
        { bf16x8 wh[4][2], wl[4][2];
          PHN(WO(2), ph_ln1_pro(p, layer, lcnt, wh, wl));
          PHN(ph_ln1(p, layer, rq, lcnt, lbase, lasg, lds, wh, wl), NOPRO); }
        PHN(ph_moe_up(p, layer, lds), (ph_moe_down<1>(p, layer, lds)));
        PHN((ph_moe_down<2>(p, layer, lds)), NOPRO);
        { LOADP; ph_ln2(p, layer, rq, pst, (const LAS int*)(lds + LDS_CTL + LC_TILE0), kind == 0 ? (G1F8 & 2u) != 0u : kind == 1 ? (G1F8 & 4u) != 0u : (G1F8 & 1u) != 0u); }
        if (layer + 1 < DEPTH) { const XbTicket tk_ = xcd_arrive(bar); { LOADP; GEMM1(1, layer + 1); } xcd_wait(bar, tk_); }
    }
#undef PHN
#undef GEMM1
#undef WO
#undef LOADP
#undef NOPRO
}

extern "C" void kernel_launch(void* const* d_in, const int* in_sizes, int n_in, void* d_out, int out_size, void* d_ws, size_t ws_size, hipStream_t stream) {
    static int grid = 0;
    if (grid == 0) {
        if (n_in != 27 || out_size != ML * D || ws_size < WS_END) { fprintf(stderr, "kernel_launch: unexpected shapes (n_in %d out %d ws %zu need %zu)\n", n_in, out_size, ws_size, (size_t)WS_END); grid = -1; return; }
        int dev = 0, cus = 0, per_cu = 0;
        if (hipGetDevice(&dev) != hipSuccess || hipDeviceGetAttribute(&cus, hipDeviceAttributeMultiprocessorCount, dev) != hipSuccess) { grid = -1; return; }
        if (hipFuncSetAttribute((const void*)mk_fwd, hipFuncAttributeMaxDynamicSharedMemorySize, LDS_BYTES) != hipSuccess) { fprintf(stderr, "kernel_launch: hipFuncSetAttribute failed\n"); grid = -1; return; }
        if (hipOccupancyMaxActiveBlocksPerMultiprocessor(&per_cu, (const void*)mk_fwd, NTHR, LDS_BYTES) != hipSuccess || per_cu < 1) fprintf(stderr, "kernel_launch: occupancy query says %d\n", per_cu);
        (void)hipGetLastError();
        grid = cus;
    }
    if (grid < 0) return;
    (void)hipMemsetAsync((char*)d_ws + WS_CTL, 0, CTL_BYTES, stream);
    Args a{};
    for (int i = 0; i < 27; ++i) a.p.in[i] = (const float*)d_in[i];
    a.p.out = (float*)d_out; a.p.ws = (unsigned char*)d_ws; a.lo = 0; a.hi = 1000;
    hipLaunchKernelGGL(mk_fwd, dim3(grid), dim3(NTHR), LDS_BYTES, stream, a);
}
```

```cpp
#include <hip/hip_runtime.h>
#include <cstdio>
#include <cstdint>
#include <cmath>
#include <hip/hip_bf16.h>

#define LAS __attribute__((address_space(3)))
typedef unsigned short bf16;
typedef short bf16x8 __attribute__((ext_vector_type(8)));
typedef float f32x4 __attribute__((ext_vector_type(4)));
typedef float f32x2 __attribute__((ext_vector_type(2)));
typedef unsigned u32x4 __attribute__((ext_vector_type(4)));
typedef unsigned u32x2 __attribute__((ext_vector_type(2)));

constexpr int D = 1024, NB = 8, SEQ = 4096, CL = 256, ML = NB * SEQ, MZ = NB * CL, M = ML + MZ, DEPTH = 4;
constexpr int NE = 32, TOPK = 4, DFF = 1024, QKVD = 1536;
constexpr int CAP = M;
constexpr int TM = 256;
constexpr int PMAX = 147456;
constexpr float DN_ALPHA = 1.681792830507429f;
constexpr float LN_EPS = 1e-5f, RMS_EPS = 1e-6f;

constexpr size_t MiB = 1u << 20;
constexpr size_t WS_CTL = 0, CTL_BYTES = 1 * MiB;
constexpr size_t WS_MOD = 1 * MiB;
constexpr size_t WS_ROPE = 2 * MiB;
constexpr size_t WS_ASG = 3 * MiB;
constexpr size_t WS_GATE = 4 * MiB;
constexpr size_t WS_TOKL = 5 * MiB;
constexpr size_t WS_X = 16 * MiB;
constexpr size_t WS_H = WS_X + 136 * MiB;
constexpr size_t WS_BIG = WS_H + 68 * MiB;
constexpr size_t WS_O = WS_BIG + 204 * MiB;
constexpr size_t WS_MX = WS_O + 68 * MiB;
constexpr size_t WS_ACT = WS_MX + 68 * MiB;
constexpr size_t WS_OUTE = WS_ACT + 288 * MiB;
constexpr size_t WS_WT = WS_OUTE + 288 * MiB;
constexpr int WT_WINQKV = 0, WT_WINWO = 3072, WT_CONVIN = 5120, WT_CONVOUT = 8192, WT_FULLQKV = 9216, WT_FULLWO = 10752, WT_ROWS = 11776;
constexpr size_t WS_WGU = WS_WT + 24 * MiB;
constexpr size_t WS_WDN = WS_WGU + 512 * MiB;
constexpr size_t WS_H8 = WS_WDN + 256 * MiB;
constexpr size_t WS_END = WS_H8 + 40 * MiB;
constexpr int CW_CNT = 64;
constexpr int CW_BAR = 4096;

__device__ __forceinline__ float bf2f(unsigned v) { return __uint_as_float(v << 16); }
__device__ __forceinline__ unsigned f2bf(float f) { unsigned u = __float_as_uint(f); return (u + 0x7fffu + ((u >> 16) & 1u)) >> 16; }
typedef __bf16 bf16x2_hw __attribute__((ext_vector_type(2)));
__device__ __forceinline__ unsigned pk2(float lo, float hi) { const f32x2 v = {lo, hi}; return __builtin_bit_cast(unsigned, __builtin_convertvector(v, bf16x2_hw)); }
__device__ __forceinline__ unsigned pk4_fp8(float a, float b, float c, float d) { int w = __builtin_amdgcn_cvt_pk_fp8_f32(a, b, 0, false); w = __builtin_amdgcn_cvt_pk_fp8_f32(c, d, w, true); return (unsigned)w; }
constexpr int WTAB_LDS = 131072 + 3584;
__device__ __forceinline__ unsigned hw_slot() { return (unsigned)__builtin_amdgcn_s_getreg((5 << 11) | 4) & 63u; }
__device__ __forceinline__ int tidx() {
    extern __shared__ __attribute__((aligned(16))) unsigned char lds_raw[];
    const int w = __builtin_amdgcn_readfirstlane(*(const LAS int*)((LAS unsigned char*)lds_raw + WTAB_LDS + 4 * hw_slot()));
    int t = (w << 6) | (int)__builtin_amdgcn_mbcnt_hi(~0u, __builtin_amdgcn_mbcnt_lo(~0u, 0u));
    asm volatile("" : "+v"(t)); return t; }
__device__ __forceinline__ int lane_op() { int l = (int)__builtin_amdgcn_mbcnt_hi(~0u, __builtin_amdgcn_mbcnt_lo(~0u, 0u)); asm volatile("" : "+v"(l)); return l; }
__device__ __forceinline__ float shx(float v, int o, int l) { return __int_as_float(__builtin_amdgcn_ds_bpermute((l ^ o) << 2, __float_as_int(v))); }
template <int CTRL> __device__ __forceinline__ float dppf(float v) { return __builtin_bit_cast(float, __builtin_amdgcn_update_dpp(0, __builtin_bit_cast(int, v), CTRL, 0xF, 0xF, false)); }
__device__ __forceinline__ float wave_sum(float v) {
    v += dppf<0xB1>(v); v += dppf<0x4E>(v); v += dppf<0x124>(v); v += dppf<0x128>(v);
    { const auto r = __builtin_amdgcn_permlane16_swap(__float_as_uint(v), __float_as_uint(v), false, false); v = __uint_as_float(r[0]) + __uint_as_float(r[1]); }
    { const auto r = __builtin_amdgcn_permlane32_swap(__float_as_uint(v), __float_as_uint(v), false, false); v = __uint_as_float(r[0]) + __uint_as_float(r[1]); }
    return v;
}
__device__ __forceinline__ int mod_row(int row) { return row < ML ? (row >> 12) : 8; }
__device__ __forceinline__ f32x4 bf4(u32x2 w) { return (f32x4){bf2f(w.x & 0xffffu), bf2f(w.x >> 16), bf2f(w.y & 0xffffu), bf2f(w.y >> 16)}; }
__device__ __forceinline__ u32x2 pk4(f32x4 v) { u32x2 w; w.x = pk2(v.x, v.y); w.y = pk2(v.z, v.w); return w; }

struct Ptrs {
    const float* in[27];
    float* out;
    unsigned char* ws;
};
#define P_X(p) ((bf16*)((p).ws + WS_X))
#define P_H(p) ((bf16*)((p).ws + WS_H))
#define P_BIG(p) ((bf16*)((p).ws + WS_BIG))
#define P_O(p) ((bf16*)((p).ws + WS_O))
#define P_MX(p) ((bf16*)((p).ws + WS_MX))
#define P_ACT(p) ((bf16*)((p).ws + WS_ACT))
#define P_OUTE(p) ((bf16*)((p).ws + WS_OUTE))
#define P_MOD(p) ((float*)((p).ws + WS_MOD))
#define P_ROPE(p) ((f32x2*)((p).ws + WS_ROPE))
#define P_ASG(p) ((int*)((p).ws + WS_ASG))
#define P_GATE(p) ((float*)((p).ws + WS_GATE))
#define P_TOKL(p) ((int*)((p).ws + WS_TOKL))
#define P_CTL(p) ((unsigned*)((p).ws + WS_CTL))
#define P_WT(p) ((bf16*)((p).ws + WS_WT))
#define P_WGU(p) ((bf16*)((p).ws + WS_WGU))
#define P_WDN(p) ((bf16*)((p).ws + WS_WDN))
#define P_H8(p) ((unsigned char*)((p).ws + WS_H8))
#define P_WGU8(p) ((unsigned char*)((p).ws + WS_WGU))
#define P_WDN8(p) ((unsigned char*)((p).ws + WS_WDN))
#define P_ACT8(p) ((unsigned char*)((p).ws + WS_ACT))
#define P_OUTE8(p) ((unsigned char*)((p).ws + WS_OUTE))
#define P_O8(p) ((unsigned char*)((p).ws + WS_O))
#define P_WO8(p) ((unsigned char*)((p).ws + WS_H8 + 35 * MiB))
constexpr unsigned G1F8 = 0b101;
#define P_H8A(p) ((unsigned char*)((p).ws + WS_H))
#define P_WQ8W(p, j) ((unsigned char*)((p).ws + WS_WT) + (size_t)WT_WINWO * D * 2 + (size_t)(j) * QKVD * D)
#define P_WQ8F(p) ((unsigned char*)((p).ws + WS_WT) + (size_t)WT_FULLWO * D * 2)
constexpr float OSC_ATT = 16.f, OSC_CONV = 8.f;


constexpr int LDS_CTL = 131072;
constexpr int LC_BAR = 0, LC_LCNT = 64, LC_LBASE = 192, LC_PST = 320, LC_CNT = 448, LC_TILE0 = 576, LC_LASG = 1024;
constexpr int LC_WTAB = 3584;
static_assert(WTAB_LDS == LDS_CTL + LC_WTAB, "tidx table");
constexpr int LC_UINFO = 720;
constexpr int LC_TOKT = 4096;
constexpr int LC_BIAS = 13312;
constexpr int LDS_BYTES = 163840;
constexpr int NTHR = 512;

#define XB_TMO      128
#define XB_XCNT(j)  (256  + 64 * (j))
#define XB_XSUB(j)  (1280 + 64 * (j))
#define XB_XGEN(j)  (2304 + 64 * (j))
#define XB_TOP      3328
#define XB_TOPGEN   3392
#define XCD_BAR_WORDS 3456
#define XB_SPIN_CAP (1u << 18)

__device__ __forceinline__ unsigned xb_ld(unsigned* p)              { return __hip_atomic_load(p, __ATOMIC_RELAXED, __HIP_MEMORY_SCOPE_AGENT); }
__device__ __forceinline__ unsigned xb_add(unsigned* p, unsigned v) { return __hip_atomic_fetch_add(p, v, __ATOMIC_RELAXED, __HIP_MEMORY_SCOPE_AGENT); }
__device__ __forceinline__ unsigned xb_xcc_id() { return (unsigned)__builtin_amdgcn_s_getreg((3 << 11) | 20) & 0xFu; }
#define XB_SPIN(cond, bar) do { unsigned _sp = 0; while (cond) { __builtin_amdgcn_s_sleep(1); \
    if ((++_sp & 255u) == 0u) { if (xb_ld(&(bar)[XB_TMO])) break; if (_sp > XB_SPIN_CAP) { atomicAdd(&(bar)[XB_TMO], 1u); break; } } } } while (0)

struct XcdBarrier {
    unsigned* bar; unsigned x;
    volatile LAS unsigned* st;
};

__device__ __forceinline__ XcdBarrier xcd_barrier_post(unsigned* bar, volatile LAS unsigned* st) {
    XcdBarrier b; b.bar = bar; b.x = xb_xcc_id(); b.st = st;
    if (tidx() == 0) (void)xb_add(&bar[XB_XCNT(b.x)], 1u);
    return b;
}
__device__ __forceinline__ void xcd_barrier_complete(unsigned* bar, unsigned x, unsigned& nloc, unsigned& nx) {
    const unsigned G = gridDim.x * gridDim.y * gridDim.z;
    unsigned sum, cnt, mine, sp = 0u;
    for (;;) {
        sum = 0u; cnt = 0u; mine = 0u;
#pragma unroll
        for (unsigned j = 0; j < 16; ++j) { const unsigned c = xb_ld(&bar[XB_XCNT(j)]); sum += c; cnt += (c > 0u) ? 1u : 0u; mine = (j == x) ? c : mine; }
        if (sum == G) break;
        __builtin_amdgcn_s_sleep(1);
        if ((++sp & 255u) == 0u) { if (xb_ld(&bar[XB_TMO])) break; if (sp > XB_SPIN_CAP) { atomicAdd(&bar[XB_TMO], 1u); break; } }
    }
    nloc = mine > 0u ? mine : 1u; nx = cnt > 0u ? cnt : 1u;
}

struct XbTicket { unsigned gen, tg; int role; };
__device__ __forceinline__ XbTicket xcd_arrive(const XcdBarrier& b) {
    XbTicket t; t.gen = 0u; t.tg = 0u; t.role = 0;
    asm volatile("s_waitcnt vmcnt(0)" ::: "memory");
    __syncthreads();
    if (tidx() == 0) {
        unsigned* bar = b.bar; asm volatile("" : "+s"(bar)); const unsigned bx = __builtin_amdgcn_readfirstlane(b.x);
        __builtin_amdgcn_s_waitcnt(0);
        unsigned nloc = b.st[0], nx = b.st[1];
        if (nloc == 0u) { xcd_barrier_complete(bar, bx, nloc, nx); b.st[0] = nloc; b.st[1] = nx; }
        const unsigned old = xb_add(&bar[XB_XSUB(bx)], 1u);
        const unsigned gen = old / nloc; t.gen = gen;
        if (old + 1u == (gen + 1u) * nloc) {
            __builtin_amdgcn_fence(__ATOMIC_RELEASE, "agent");
            asm volatile("s_waitcnt vmcnt(0)" ::: "memory");
            const unsigned og = xb_add(&bar[XB_TOP], 1u);
            const unsigned tg = og / nx; t.tg = tg; t.role = 1;
            if (og + 1u == (tg + 1u) * nx) { xb_add(&bar[XB_TOPGEN], 1u); t.role = 2; }
        }
    }
    return t;
}
__device__ __forceinline__ void xcd_wait(const XcdBarrier& b, const XbTicket& t) {
    if (tidx() == 0) {
        unsigned* bar = b.bar; asm volatile("" : "+s"(bar)); const unsigned bx = __builtin_amdgcn_readfirstlane(b.x);
        if (t.role != 0) {
            if (t.role == 1) XB_SPIN(xb_ld(&bar[XB_TOPGEN]) == t.tg, bar);
            __builtin_amdgcn_fence(__ATOMIC_ACQUIRE, "agent");
            xb_add(&bar[XB_XGEN(bx)], 1u);
            asm volatile("s_waitcnt vmcnt(0)" ::: "memory");
        } else {
            XB_SPIN(xb_ld(&bar[XB_XGEN(bx)]) == t.gen, bar);
            __builtin_amdgcn_fence(__ATOMIC_ACQUIRE, "agent");
            asm volatile("s_waitcnt vmcnt(0)" ::: "memory");
        }
    }
    __syncthreads();
}

__device__ __forceinline__ void ph_mod(const Ptrs& p, LAS unsigned char* lds) {
    const int TX = tidx();
    LAS float* s = (LAS float*)lds; LAS float* red = (LAS float*)(lds + 36864);
    for (int i = TX; i < 9 * 1024; i += NTHR) { const int r = i >> 10, k = i & 1023; const float v = r < 8 ? p.in[1][r * 1024 + k] : p.in[3][k]; s[i] = v / (1.f + __expf(-v)); }
    __syncthreads();
    const int n = TX & 63, ks = TX >> 6;
    for (int item = blockIdx.x; item < 384; item += gridDim.x) {
        const int l = item / 96, nc = item % 96;
        float acc[9];
#pragma unroll
        for (int r = 0; r < 9; ++r) acc[r] = 0.f;
        const float* w = p.in[4] + ((size_t)l * 1024 + ks * 128) * 6144 + nc * 64 + n; const LAS float* sk = s + ks * 128;
#pragma unroll 16
        for (int k = 0; k < 128; ++k) { const float wv = w[(size_t)k * 6144];
#pragma unroll
            for (int r = 0; r < 9; ++r) acc[r] += sk[r * 1024 + k] * wv; }
#pragma unroll
        for (int r = 0; r < 9; ++r) red[(ks * 9 + r) * 64 + n] = acc[r];
        __syncthreads();
        for (int idx = TX; idx < 576; idx += NTHR) { const int r = idx >> 6, nn = idx & 63; float a = p.in[5][l * 6144 + nc * 64 + nn];
#pragma unroll
            for (int q = 0; q < 8; ++q) a += red[(q * 9 + r) * 64 + nn];
            P_MOD(p)[((size_t)l * 9 + r) * 6144 + nc * 64 + nn] = a; }
        __syncthreads();
    }
    if (blockIdx.x == gridDim.x - 1) {
        for (int i = TX; i < 64 * 16; i += NTHR) { const int pos = i >> 4, f = i & 15; const float inv = exp2f(-(float)f * (1.f / 16.f) * 13.287712379549449f); const float a = (float)pos * inv;
            P_ROPE(p)[i] = (f32x2){cosf(a), sinf(a)}; }
    }
    __syncthreads();
}

#define ROW_LOOP(nrows) const int tx_ = tidx(), lane = tx_ & 63, wave = tx_ >> 6, nwv = NTHR >> 6; for (int row = blockIdx.x * nwv + wave; row < (nrows); row += gridDim.x * nwv)
#define PAIR_LOOP(nrows) const int tx_ = tidx(), lane = tx_ & 63, wave = tx_ >> 6, rstride = (int)gridDim.x * 8; for (int row0 = blockIdx.x * 8 + wave, it = 0; row0 < (nrows); row0 += 2 * rstride, it += 2)
#define PAIR_ROWS(nrows) int row[2]; row[0] = row0; row[1] = row0 + rstride; const bool ok1 = row[1] < (nrows); if (!ok1) row[1] = row0
__device__ __forceinline__ void ld_bf8(const bf16* rowp, int lane, int jj, float (&o)[8]) { const u32x4 w = *(const u32x4*)(rowp + 8 * (lane + 64 * jj));
    o[0] = bf2f(w.x & 0xffffu); o[1] = bf2f(w.x >> 16); o[2] = bf2f(w.y & 0xffffu); o[3] = bf2f(w.y >> 16); o[4] = bf2f(w.z & 0xffffu); o[5] = bf2f(w.z >> 16); o[6] = bf2f(w.w & 0xffffu); o[7] = bf2f(w.w >> 16); }
__device__ __forceinline__ void ld_q8(const unsigned char* rowp, int lane, int jj, float (&o)[8]) { const u32x2 w = *(const u32x2*)(rowp + 8 * (lane + 64 * jj));
    const f32x2 a = __builtin_amdgcn_cvt_pk_f32_fp8((int)w.x, false), b = __builtin_amdgcn_cvt_pk_f32_fp8((int)w.x, true), c = __builtin_amdgcn_cvt_pk_f32_fp8((int)w.y, false), d = __builtin_amdgcn_cvt_pk_f32_fp8((int)w.y, true);
    o[0] = a.x; o[1] = a.y; o[2] = b.x; o[3] = b.y; o[4] = c.x; o[5] = c.y; o[6] = d.x; o[7] = d.y; }
__device__ __forceinline__ void un_bf8(const u32x4 w, float (&o)[8]) { o[0] = bf2f(w.x & 0xffffu); o[1] = bf2f(w.x >> 16); o[2] = bf2f(w.y & 0xffffu); o[3] = bf2f(w.y >> 16); o[4] = bf2f(w.z & 0xffffu); o[5] = bf2f(w.z >> 16); o[6] = bf2f(w.w & 0xffffu); o[7] = bf2f(w.w >> 16); }
__device__ __forceinline__ void ld_f8(const float* rowp, int lane, int jj, float (&o)[8]) { const f32x4 a = *(const f32x4*)(rowp + 8 * (lane + 64 * jj)), b = *(const f32x4*)(rowp + 8 * (lane + 64 * jj) + 4);
    o[0] = a.x; o[1] = a.y; o[2] = a.z; o[3] = a.w; o[4] = b.x; o[5] = b.y; o[6] = b.z; o[7] = b.w; }
__device__ __forceinline__ void st_bf8(bf16* rowp, int lane, int jj, const float (&v)[8]);
__device__ __forceinline__ void st_bf8(bf16* rowp, int lane, int jj, const float (&v)[8]) { u32x4 w; w.x = pk2(v[0], v[1]); w.y = pk2(v[2], v[3]); w.z = pk2(v[4], v[5]); w.w = pk2(v[6], v[7]); *(u32x4*)(rowp + 8 * (lane + 64 * jj)) = w; }
__device__ __forceinline__ void st_h(unsigned char* hbase, int row, int lane, int jj, const float (&h)[8], bool f8) {
    asm volatile("" : "+v"(lane));
    if (f8) { u32x2 w; w.x = pk4_fp8(h[0], h[1], h[2], h[3]); w.y = pk4_fp8(h[4], h[5], h[6], h[7]); *(u32x2*)(hbase + (size_t)row * D + 8 * (lane + 64 * jj)) = w; }
    else st_bf8((bf16*)hbase + (size_t)row * D, lane, jj, h); }
__device__ __forceinline__ void st_f8(float* rowp, int lane, int jj, const float (&v)[8]) { *(f32x4*)(rowp + 8 * (lane + 64 * jj)) = (f32x4){v[0], v[1], v[2], v[3]}; *(f32x4*)(rowp + 8 * (lane + 64 * jj) + 4) = (f32x4){v[4], v[5], v[6], v[7]}; }

__device__ __forceinline__ void ph_input(const Ptrs& p) {
    {
        const int tx0 = tidx(), ln0 = tx0 & 63, gw = blockIdx.x * 8 + (tx0 >> 6), NGW = gridDim.x * 8; float* RAB = (float*)(p.ws + WS_MOD + 896 * 1024);
        for (int it = gw; it < 1152; it += NGW) { const int e = it & 31, lm = it >> 5, layer = lm / 9;
            const float* md = P_MOD(p) + (size_t)lm * 6144; const float* g = p.in[6] + layer * D; const float* bb = p.in[7] + layer * D; const float* rw = p.in[21] + (size_t)layer * D * NE;
            float sa = 0.f, sb = 0.f;
            for (int k = ln0; k < D; k += 64) { const float w = rw[(size_t)k * NE + e], sc = md[4096 + k], sh = md[3072 + k]; sa += g[k] * (1.f + sc) * w; sb += (bb[k] * (1.f + sc) + sh) * w; }
            sa = wave_sum(sa); sb = wave_sum(sb);
            if (ln0 == 0) { RAB[it] = sa; RAB[1152 + it] = sb + p.in[22][layer * NE + e]; } }
    }
    PAIR_LOOP(M) { PAIR_ROWS(M);
#pragma unroll
        for (int r = 0; r < 2; ++r) {
            const float* src = row[r] < ML ? p.in[0] + (size_t)row[r] * D : p.in[2] + (size_t)(row[r] - ML) * D; const float* md = P_MOD(p) + (size_t)mod_row(row[r]) * 6144;
#pragma unroll
            for (int jj = 0; jj < 2; ++jj) { float v[8], sh[8], sc[8], h[8]; ld_f8(src, lane, jj, v); ld_f8(md, lane, jj, sh); ld_f8(md + 1024, lane, jj, sc);
#pragma unroll
                for (int i = 0; i < 8; ++i) h[i] = v[i] * (1.f + sc[i]) + sh[i];
                if (r == 0 || ok1) { st_bf8(P_X(p) + (size_t)row[r] * D, lane, jj, v); st_h((unsigned char*)P_H(p), row[r], lane, jj, h, (G1F8 & 1u) != 0u); } }
        }
    }
}

template <int KIND> __device__ __forceinline__ void ph_kproc(const Ptrs& p, const float* kn) {
    PAIR_LOOP(M) { PAIR_ROWS(M);
        const int l16 = lane & 15;
#pragma unroll
        for (int r = 0; r < 2; ++r) {
            bf16* kp = P_BIG(p) + (size_t)row[r] * QKVD + 1024 + lane * 4; const u32x2 w = *(const u32x2*)kp;
            float v[4]; v[0] = bf2f(w.x & 0xffffu); v[1] = bf2f(w.x >> 16); v[2] = bf2f(w.y & 0xffffu); v[3] = bf2f(w.y >> 16);
            if (KIND == 2) { float ss = (v[0] * v[0] + v[1] * v[1]) + (v[2] * v[2] + v[3] * v[3]); { const int l_ = lane_op(); ss += shx(ss, 1, l_); ss += shx(ss, 2, l_); ss += shx(ss, 4, l_); ss += shx(ss, 8, l_); }
                const float rs = 1.0f / sqrtf(ss * (1.f / 64.f) + RMS_EPS); const f32x4 g = *(const f32x4*)(kn + 4 * l16);
                v[0] *= rs * g.x; v[1] *= rs * g.y; v[2] *= rs * g.z; v[3] *= rs * g.w; }
            if (row[r] < ML) { const int t = row[r] & 4095, axis = l16 >> 3, half = (l16 >> 2) & 1, pos = axis ? (t & 63) : (t >> 6);
                const f32x4* cp = (const f32x4*)(P_ROPE(p) + pos * 16 + 4 * (l16 & 3)); const f32x4 c01 = cp[0], c23 = cp[1];
                const float cs[4] = {c01.x, c01.z, c23.x, c23.z}, sn[4] = {c01.y, c01.w, c23.y, c23.w};
#pragma unroll
                for (int i = 0; i < 4; ++i) { const float o = shx(v[i], 4, lane_op()); v[i] = half == 0 ? v[i] * cs[i] - o * sn[i] : v[i] * cs[i] + o * sn[i]; } }
            if (r == 0 || ok1) { u32x2 o; o.x = pk2(v[0], v[1]); o.y = pk2(v[2], v[3]); *(u32x2*)kp = o; }
        }
    }
}

__device__ __forceinline__ void ph_conv(const Ptrs& p, const float* cw, int nrows) {
    PAIR_LOOP(nrows) { PAIR_ROWS(nrows);
#pragma unroll
        for (int r = 0; r < 2; ++r) {
            const int t = row[r] < ML ? (row[r] & 4095) : ((row[r] - ML) & 255), tl = row[r] < ML ? 4095 : 255;
            const bool vp = t != 0, vn = t != tl;
            const bf16* u = P_BIG(p) + (size_t)row[r] * 3072;
#pragma unroll
            for (int jj = 0; jj < 2; ++jj) {
                float b[8], c0[8], x0[8], cp[8], xp[8], cn[8], xn[8], w0[8], w1[8], w2[8], y[8];
                ld_bf8(u, lane, jj, b); ld_bf8(u + 1024, lane, jj, c0); ld_bf8(u + 2048, lane, jj, x0);
#pragma unroll
                for (int i = 0; i < 8; ++i) { cp[i] = 0.f; xp[i] = 0.f; cn[i] = 0.f; xn[i] = 0.f; }
                if (vp) { ld_bf8(u - 3072 + 1024, lane, jj, cp); ld_bf8(u - 3072 + 2048, lane, jj, xp); }
                if (vn) { ld_bf8(u + 3072 + 1024, lane, jj, cn); ld_bf8(u + 3072 + 2048, lane, jj, xn); }
                ld_f8(cw, lane, jj, w0); ld_f8(cw + 1024, lane, jj, w1); ld_f8(cw + 2048, lane, jj, w2);
#pragma unroll
                for (int i = 0; i < 8; ++i) y[i] = b[i] * (w0[i] * (cp[i] * xp[i]) + w1[i] * (c0[i] * x0[i]) + w2[i] * (cn[i] * xn[i]));
                if (r == 0 || ok1) { float c8[8];
#pragma unroll
                    for (int i = 0; i < 8; ++i) c8[i] = fminf(fmaxf(y[i] * OSC_CONV, -448.f), 448.f);
                    u32x2 w8; w8.x = pk4_fp8(c8[0], c8[1], c8[2], c8[3]); w8.y = pk4_fp8(c8[4], c8[5], c8[6], c8[7]); *(u32x2*)(P_O8(p) + (size_t)row[r] * D + 8 * (lane + 64 * jj)) = w8; }
            }
        }
    }
}

constexpr int MAXR = 160;
#define P_RAB(p) ((float*)((p).ws + WS_MOD + 896 * 1024))
__device__ __forceinline__ void ph_ln1_pro(const Ptrs& p, int layer, LAS int* lcnt  , bf16x8 (&wh)[4][2], bf16x8 (&wl)[4][2]) {
    const int TX = tidx(), lane = TX & 63, wave = TX >> 6;
    const float* rw = p.in[21] + (size_t)layer * D * NE;
    if (TX < 32) lcnt[TX] = 0;
    { const int r = lane & 15, kb = 128 * wave + 8 * (lane >> 4);
#pragma unroll
    for (int ks = 0; ks < 4; ++ks)
#pragma unroll
        for (int eb = 0; eb < 2; ++eb) { u32x4 h4, l4;
#pragma unroll
            for (int i = 0; i < 4; ++i) { const float w0 = rw[(size_t)(kb + 32 * ks + 2 * i) * NE + 16 * eb + r], w1 = rw[(size_t)(kb + 32 * ks + 2 * i + 1) * NE + 16 * eb + r];
                const unsigned hp = pk2(w0, w1); h4[i] = hp; l4[i] = pk2(w0 - __uint_as_float(hp << 16), w1 - __uint_as_float(hp & 0xffff0000u)); }
            wh[ks][eb] = __builtin_bit_cast(bf16x8, h4); wl[ks][eb] = __builtin_bit_cast(bf16x8, l4); } }
}
__device__ __forceinline__ void ph_ln1(const Ptrs& p, int layer, int nrows, LAS int* lcnt  , LAS int* lbase  , LAS int* lasg  , LAS unsigned char* lds  , const bf16x8 (&wh)[4][2], const bf16x8 (&wl)[4][2]) {
    const int TX = tidx(), lane = TX & 63, wave = TX >> 6;
    const float* g = p.in[6] + layer * D; const float* bb = p.in[7] + layer * D;
    unsigned* cnt = P_CTL(p) + CW_CNT + layer * 64;
    __syncthreads();
    const int ngr = nrows >> 4, G = (int)gridDim.x;
    LAS float* part = (LAS float*)lds;
    LAS float* stat = (LAS float*)(lds + 32768);
    const float* RAB = P_RAB(p) + layer * 288;
    u32x4 xq[4], mq[4];
    { const size_t ro = (size_t)(blockIdx.x * 16 + (lane & 15)) * D + 128 * wave + 8 * (lane >> 4);
#pragma unroll
      for (int ks = 0; ks < 4; ++ks) { xq[ks] = *(const u32x4*)(P_X(p) + ro + 32 * ks); mq[ks] = *(const u32x4*)(P_MX(p) + ro + 32 * ks); } }
    int gi = 0;
    for (int gq = blockIdx.x; gq < ngr; gq += G, ++gi) {
        int lx = lane; asm volatile("" : "+v"(lx));
        const int r = lx & 15, q = lx >> 4, kb = 128 * wave + 8 * q;
        const int mr = mod_row(gq * 16); const float* md = P_MOD(p) + ((size_t)layer * 9 + mr) * 6144;
        const float ra_ = RAB[mr * 32 + (lx & 31)], rb_ = RAB[1152 + mr * 32 + (lx & 31)];
        float y[4][8]; float s1 = 0.f, s2 = 0.f;
#pragma unroll
        for (int ks = 0; ks < 4; ++ks) { float x[8], m[8]; const f32x4 ga = *(const f32x4*)(md + 2048 + kb + 32 * ks), gb = *(const f32x4*)(md + 2048 + kb + 32 * ks + 4);
            const float g1[8] = {ga.x, ga.y, ga.z, ga.w, gb.x, gb.y, gb.z, gb.w}; un_bf8(xq[ks], x); un_bf8(mq[ks], m);
#pragma unroll
            for (int i = 0; i < 8; ++i) { const float v = x[i] * DN_ALPHA + g1[i] * m[i]; y[ks][i] = v; s1 += v; s2 += v * v; } }
        __builtin_amdgcn_sched_barrier(0);
        { const int gn = gq + G; if (gn < ngr) { const size_t ro = (size_t)(gn * 16 + r) * D + kb;
#pragma unroll
            for (int ks = 0; ks < 4; ++ks) { xq[ks] = *(const u32x4*)(P_X(p) + ro + 32 * ks); mq[ks] = *(const u32x4*)(P_MX(p) + ro + 32 * ks); } } }
        __builtin_amdgcn_sched_barrier(0);
        f32x4 acc[2] = {(f32x4){0.f, 0.f, 0.f, 0.f}, (f32x4){0.f, 0.f, 0.f, 0.f}};
#pragma unroll
        for (int ks = 0; ks < 4; ++ks) { const f32x4 ga = *(const f32x4*)(g + kb + 32 * ks), gb = *(const f32x4*)(g + kb + 32 * ks + 4), ca = *(const f32x4*)(md + 4096 + kb + 32 * ks), cb = *(const f32x4*)(md + 4096 + kb + 32 * ks + 4);
            const float a[8] = {ga.x * (1.f + ca.x), ga.y * (1.f + ca.y), ga.z * (1.f + ca.z), ga.w * (1.f + ca.w), gb.x * (1.f + cb.x), gb.y * (1.f + cb.y), gb.z * (1.f + cb.z), gb.w * (1.f + cb.w)};
            u32x4 zh, zl;
#pragma unroll
            for (int i = 0; i < 4; ++i) { const float z0 = y[ks][2 * i] * a[2 * i], z1 = y[ks][2 * i + 1] * a[2 * i + 1]; const unsigned hp = pk2(z0, z1);
                zh[i] = hp; zl[i] = pk2(z0 - __uint_as_float(hp << 16), z1 - __uint_as_float(hp & 0xffff0000u)); }
            const bf16x8 zhv = __builtin_bit_cast(bf16x8, zh), zlv = __builtin_bit_cast(bf16x8, zl);
#pragma unroll
            for (int eb = 0; eb < 2; ++eb) {
                acc[eb] = __builtin_amdgcn_mfma_f32_16x16x32_bf16(wh[ks][eb], zhv, acc[eb], 0, 0, 0);
                acc[eb] = __builtin_amdgcn_mfma_f32_16x16x32_bf16(wl[ks][eb], zhv, acc[eb], 0, 0, 0);
                acc[eb] = __builtin_amdgcn_mfma_f32_16x16x32_bf16(wh[ks][eb], zlv, acc[eb], 0, 0, 0); } }
        s1 += shx(s1, 16, lx); s1 += shx(s1, 32, lx); s2 += shx(s2, 16, lx); s2 += shx(s2, 32, lx);
        const int buf = gi & 1;
        { LAS float* pw = part + ((buf * 8 + wave) * 16 + r) * 32 + 4 * q; *(LAS f32x4*)pw = acc[0]; *(LAS f32x4*)(pw + 16) = acc[1];
          if (q == 0) *(LAS f32x2*)(stat + ((buf * 8 + wave) * 16 + r) * 2) = (f32x2){s1, s2}; }
        __syncthreads();
        float t1 = 0.f, t2 = 0.f;
#pragma unroll
        for (int w = 0; w < 8; ++w) { const f32x2 sv = *(const LAS f32x2*)(stat + ((buf * 8 + w) * 16 + r) * 2); t1 += sv.x; t2 += sv.y; }
        const float mean = t1 * (1.f / D), rstd = 1.f / sqrtf(fmaxf(t2 * (1.f / D) - mean * mean, 0.f) + LN_EPS);
#pragma unroll
        for (int ks = 0; ks < 4; ++ks) { const int kc = kb + 32 * ks; float gg[8], gb[8], sc[8], sh[8], xn[8], hv[8];
            { const f32x4 a0 = *(const f32x4*)(g + kc), a1 = *(const f32x4*)(g + kc + 4), b0 = *(const f32x4*)(bb + kc), b1 = *(const f32x4*)(bb + kc + 4), c0 = *(const f32x4*)(md + 4096 + kc), c1 = *(const f32x4*)(md + 4096 + kc + 4), d0 = *(const f32x4*)(md + 3072 + kc), d1 = *(const f32x4*)(md + 3072 + kc + 4);
              gg[0] = a0.x; gg[1] = a0.y; gg[2] = a0.z; gg[3] = a0.w; gg[4] = a1.x; gg[5] = a1.y; gg[6] = a1.z; gg[7] = a1.w; gb[0] = b0.x; gb[1] = b0.y; gb[2] = b0.z; gb[3] = b0.w; gb[4] = b1.x; gb[5] = b1.y; gb[6] = b1.z; gb[7] = b1.w;
              sc[0] = c0.x; sc[1] = c0.y; sc[2] = c0.z; sc[3] = c0.w; sc[4] = c1.x; sc[5] = c1.y; sc[6] = c1.z; sc[7] = c1.w; sh[0] = d0.x; sh[1] = d0.y; sh[2] = d0.z; sh[3] = d0.w; sh[4] = d1.x; sh[5] = d1.y; sh[6] = d1.z; sh[7] = d1.w; }
#pragma unroll
            for (int i = 0; i < 8; ++i) { xn[i] = (y[ks][i] - mean) * rstd * gg[i] + gb[i]; hv[i] = xn[i] * (1.f + sc[i]) + sh[i]; }
            const size_t ro = (size_t)(gq * 16 + r) * D + kc;
            u32x4 xw; xw.x = pk2(xn[0], xn[1]); xw.y = pk2(xn[2], xn[3]); xw.z = pk2(xn[4], xn[5]); xw.w = pk2(xn[6], xn[7]); *(u32x4*)(P_X(p) + ro) = xw;
            u32x2 h8; h8.x = pk4_fp8(hv[0], hv[1], hv[2], hv[3]); h8.y = pk4_fp8(hv[4], hv[5], hv[6], hv[7]); *(u32x2*)(P_H8(p) + ro) = h8; }
        const int myid = lx & 31, rr = lx >> 5, lrow = 2 * wave + rr;
        float S = 0.f;
#pragma unroll
        for (int w = 0; w < 8; ++w) S += part[((buf * 8 + w) * 16 + lrow) * 32 + myid];
        const float mean_l = __int_as_float(__builtin_amdgcn_ds_bpermute(lrow << 2, __float_as_int(mean))), rstd_l = __int_as_float(__builtin_amdgcn_ds_bpermute(lrow << 2, __float_as_int(rstd)));
        float val = rstd_l * (S - mean_l * ra_) + rb_;
        LAS float* tot = (LAS float*)(lds + 36864) + lrow * 32;
        tot[myid] = val;
        asm volatile("s_waitcnt lgkmcnt(0)" ::: "memory");
        int rank = 0; float vmax = val;
#pragma unroll
        for (int j4 = 0; j4 < 8; ++j4) { const f32x4 t4 = *(const LAS f32x4*)(tot + 4 * j4); const float tj[4] = {t4.x, t4.y, t4.z, t4.w};
#pragma unroll
            for (int t = 0; t < 4; ++t) { const int j = 4 * j4 + t; rank += (tj[t] > val || (tj[t] == val && j < myid)) ? 1 : 0; vmax = fmaxf(vmax, tj[t]); } }
        const bool top = rank < 4;
        const float pe = top ? __expf(val - vmax) : 0.f; float ps = pe;
#pragma unroll
        for (int sft = 1; sft < 32; sft <<= 1) ps += shx(ps, sft, lx);
        if (top) { const int myrow = gq * 16 + lrow; const int lr = atomicAdd((int*)&lcnt[myid], 1); lasg[(gi * 16 + lrow) * 4 + rank] = myid | (lr << 8); P_GATE(p)[(size_t)myrow * 4 + rank] = pe / ps; }
    }
    __syncthreads();
    if (TX < 32) lbase[TX] = (int)__hip_atomic_fetch_add(cnt + TX, (unsigned)lcnt[TX], __ATOMIC_RELAXED, __HIP_MEMORY_SCOPE_AGENT);
    __syncthreads();
    for (int u = TX; u < gi * 64; u += NTHR) { const int li = u >> 2, row = ((int)blockIdx.x + (li >> 4) * G) * 16 + (li & 15);
        const int a = lasg[u]; const int e = a & 255, rk = lbase[e] + (a >> 8);
        P_ASG(p)[(size_t)row * 4 + (u & 3)] = e | (rk << 8); P_TOKL(p)[(size_t)e * CAP + rk] = row; }
}

__device__ __forceinline__ void ph_ln2(const Ptrs& p, int layer, int nrows, LAS int* pst  , const LAS int* tile0  , bool hf8  ) {
    const int TX = tidx();
    const float* g = p.in[8] + layer * D; const float* bb = p.in[9] + layer * D;
    const unsigned* cnt = P_CTL(p) + CW_CNT + layer * 64;
    if (TX < 32) pst[TX] = tile0[TX] * TM;
    __syncthreads();
    const bool last = layer == DEPTH - 1;
    typedef int i32x4 __attribute__((ext_vector_type(4)));
    const int tx_ = tidx(), lane = tx_ & 63, wave = tx_ >> 6, rstride = (int)gridDim.x * 8;
    i32x4 an[2]; f32x4 gn[2];
    { const int r0 = blockIdx.x * 8 + wave; if (r0 < nrows) { const int r1 = r0 + rstride < nrows ? r0 + rstride : r0;
        an[0] = *(const i32x4*)(P_ASG(p) + (size_t)r0 * 4); gn[0] = *(const f32x4*)(P_GATE(p) + (size_t)r0 * 4); an[1] = *(const i32x4*)(P_ASG(p) + (size_t)r1 * 4); gn[1] = *(const f32x4*)(P_GATE(p) + (size_t)r1 * 4); } }
    for (int row0 = blockIdx.x * 8 + wave; row0 < nrows; row0 += 2 * rstride) { PAIR_ROWS(nrows);
        i32x4 ac[2]; f32x4 gc[2]; ac[0] = an[0]; ac[1] = an[1]; gc[0] = gn[0]; gc[1] = gn[1];
        { const int n0 = row0 + 2 * rstride; if (n0 < nrows) { const int n1 = n0 + rstride < nrows ? n0 + rstride : n0;
            an[0] = *(const i32x4*)(P_ASG(p) + (size_t)n0 * 4); gn[0] = *(const f32x4*)(P_GATE(p) + (size_t)n0 * 4); an[1] = *(const i32x4*)(P_ASG(p) + (size_t)n1 * 4); gn[1] = *(const f32x4*)(P_GATE(p) + (size_t)n1 * 4); } }
        float v[2][2][8]; float s[2] = {0.f, 0.f};
#pragma unroll
        for (int r = 0; r < 2; ++r) {
            const float* md = P_MOD(p) + ((size_t)layer * 9 + mod_row(row[r])) * 6144;
            const i32x4 a = ac[r]; const f32x4 gt = gc[r];
#pragma unroll
            for (int jj = 0; jj < 2; ++jj)
#pragma unroll
                for (int i = 0; i < 8; ++i) v[r][jj][i] = 0.f;
            if (r == 1 && !ok1) continue;
#pragma unroll
            for (int k = 0; k < 4; ++k) { const int pos = pst[a[k] & 255] + (a[k] >> 8);
#pragma unroll
                for (int jj = 0; jj < 2; ++jj) { float o[8]; ld_q8(P_OUTE8(p) + (size_t)pos * D, lane, jj, o); const float gk = gt[k] * 0.25f;
#pragma unroll
                    for (int i = 0; i < 8; ++i) v[r][jj][i] += gk * o[i]; } }
#pragma unroll
            for (int jj = 0; jj < 2; ++jj) { float x[8], g2[8]; ld_bf8(P_X(p) + (size_t)row[r] * D, lane, jj, x); ld_f8(md + 5120, lane, jj, g2);
#pragma unroll
                for (int i = 0; i < 8; ++i) { v[r][jj][i] = x[i] * DN_ALPHA + g2[i] * v[r][jj][i]; s[r] += v[r][jj][i]; } }
        }
        float mean[2], rstd[2], s2[2] = {0.f, 0.f};
#pragma unroll
        for (int r = 0; r < 2; ++r) mean[r] = wave_sum(s[r]) * (1.f / D);
#pragma unroll
        for (int r = 0; r < 2; ++r)
#pragma unroll
            for (int jj = 0; jj < 2; ++jj)
#pragma unroll
                for (int i = 0; i < 8; ++i) { v[r][jj][i] -= mean[r]; s2[r] += v[r][jj][i] * v[r][jj][i]; }
#pragma unroll
        for (int r = 0; r < 2; ++r) rstd[r] = 1.f / sqrtf(wave_sum(s2[r]) * (1.f / D) + LN_EPS);
#pragma unroll
        for (int jj = 0; jj < 2; ++jj) { float gg[8], gb[8]; ld_f8(g, lane, jj, gg); ld_f8(bb, lane, jj, gb);
#pragma unroll
            for (int r = 0; r < 2; ++r) { float xn[8];
#pragma unroll
                for (int i = 0; i < 8; ++i) xn[i] = v[r][jj][i] * rstd[r] * gg[i] + gb[i];
                if (last) { if (r == 0 || ok1) st_f8(p.out + (size_t)row[r] * D, lane, jj, xn); }
                else { const float* mdn = P_MOD(p) + ((size_t)(layer + 1) * 9 + mod_row(row[r])) * 6144; float sh[8], sc[8], h[8]; ld_f8(mdn, lane, jj, sh); ld_f8(mdn + 1024, lane, jj, sc);
#pragma unroll
                    for (int i = 0; i < 8; ++i) h[i] = xn[i] * (1.f + sc[i]) + sh[i];
                    if (r == 0 || ok1) { st_bf8(P_X(p) + (size_t)row[r] * D, lane, jj, xn); st_h((unsigned char*)P_H(p), row[r], lane, jj, h, hf8); } } }
        }
    }
}


template <bool GU> __device__ __forceinline__ void tr_item(const float* W, int N, bf16* WT, int item, LAS unsigned char* t, int lane) {
    const int nb = N >> 6, k0 = (item / nb) * 64, n0 = (item % nb) * 64, q = lane >> 4, n4 = (lane & 15) * 4;
    f32x4 v[16];
#pragma unroll
    for (int i = 0; i < 16; ++i) v[i] = *(const f32x4*)(W + (size_t)(k0 + 16 * q + i) * N + n0 + n4);
#pragma unroll
    for (int j = 0; j < 4; ++j) {
        u32x4 a, b; a.x = pk2(v[0][j], v[1][j]); a.y = pk2(v[2][j], v[3][j]); a.z = pk2(v[4][j], v[5][j]); a.w = pk2(v[6][j], v[7][j]);
        b.x = pk2(v[8][j], v[9][j]); b.y = pk2(v[10][j], v[11][j]); b.z = pk2(v[12][j], v[13][j]); b.w = pk2(v[14][j], v[15][j]);
        *(LAS u32x4*)(t + (n4 + j) * 144 + q * 32) = a; *(LAS u32x4*)(t + (n4 + j) * 144 + q * 32 + 16) = b; }
    asm volatile("s_waitcnt lgkmcnt(0)" ::: "memory");
#pragma unroll
    for (int r = 0; r < 8; ++r) { const int nl = 8 * r + (lane >> 3), ch = lane & 7, n = n0 + nl;
        const int R = GU ? ((n & 1023) >> 7) * 256 + (n & 127) + (n >> 10) * 128 : n;
        *(u32x4*)(WT + (size_t)R * 1024 + k0 + ch * 8) = *(const LAS u32x4*)(t + nl * 144 + ch * 16); }
    asm volatile("s_waitcnt lgkmcnt(0)" ::: "memory");
}
template <bool GU> __device__ __forceinline__ void tr_item8(const float* W, int N, unsigned char* WT, float scale, int item, LAS unsigned char* t, int lane) {
    const int nb = N >> 6, pr = item >> 1, k0 = ((pr / nb) * 2 + (item & 1)) * 64, n0 = (pr % nb) * 64, q = lane >> 4, n4 = (lane & 15) * 4;
    f32x4 v[16];
#pragma unroll
    for (int i = 0; i < 16; ++i) v[i] = *(const f32x4*)(W + (size_t)(k0 + 16 * q + i) * N + n0 + n4) * scale;
#pragma unroll
    for (int j = 0; j < 4; ++j) { u32x4 a; a.x = pk4_fp8(v[0][j], v[1][j], v[2][j], v[3][j]); a.y = pk4_fp8(v[4][j], v[5][j], v[6][j], v[7][j]); a.z = pk4_fp8(v[8][j], v[9][j], v[10][j], v[11][j]); a.w = pk4_fp8(v[12][j], v[13][j], v[14][j], v[15][j]);
        *(LAS u32x4*)(t + (n4 + j) * 80 + q * 16) = a; }
    asm volatile("s_waitcnt lgkmcnt(0)" ::: "memory");
#pragma unroll
    for (int r = 0; r < 4; ++r) { const int nl = 16 * r + (lane >> 2), ch = lane & 3, n = n0 + nl;
        const int R = GU ? ((n & 1023) >> 7) * 256 + (n & 127) + (n >> 10) * 128 : n;
        *(u32x4*)(WT + (size_t)R * 1024 + k0 + ch * 16) = *(const LAS u32x4*)(t + nl * 80 + ch * 16); }
    asm volatile("s_waitcnt lgkmcnt(0)" ::: "memory");
}
__device__ __forceinline__ void ph_weights(const Ptrs& p, LAS unsigned char* lds) {
    const int TX = tidx(), lane = TX & 63, wave = TX >> 6, gw = blockIdx.x * 8 + wave, NGW = gridDim.x * 8;
    LAS unsigned char* t = lds + wave * 9216;
    constexpr int I15 = 16 * 24, I10 = 16 * 16, I30 = 16 * 48, I20 = 16 * 32;
    constexpr int NS = 2 * I15 + 2 * I10 + I30 + I10 + I15 + I10;
    for (int it = gw; it < NS; it += NGW) {
        int r = it; bf16* wt = P_WT(p);
        if (r < 2 * I15) { const int j = r / I15; if (G1F8 & 1u) tr_item8<false>(p.in[10] + (size_t)j * D * QKVD, QKVD, P_WQ8W(p, j), 32.f, r % I15, t, lane); else tr_item<false>(p.in[10] + (size_t)j * D * QKVD, QKVD, wt + (size_t)(WT_WINQKV + j * QKVD) * D, r % I15, t, lane); continue; } r -= 2 * I15;
        if (r < 2 * I10) { const int j = r / I10; tr_item8<false>(p.in[13] + (size_t)j * D * D, D, P_WO8(p) + (size_t)j * D * D, 64.f, r % I10, t, lane); continue; } r -= 2 * I10;
        if (r < I30) { tr_item<false>(p.in[14], 3072, wt + (size_t)WT_CONVIN * D, r, t, lane); continue; } r -= I30;
        if (r < I10) { tr_item8<false>(p.in[16], D, P_WO8(p) + (size_t)2 * D * D, 64.f, r, t, lane); continue; } r -= I10;
        if (r < I15) { if (G1F8 & 4u) tr_item8<false>(p.in[17], QKVD, P_WQ8F(p), 32.f, r, t, lane); else tr_item<false>(p.in[17], QKVD, wt + (size_t)WT_FULLQKV * D, r, t, lane); continue; } r -= I15;
        tr_item8<false>(p.in[20], D, P_WO8(p) + (size_t)3 * D * D, 64.f, r, t, lane);
    }
    for (int it = gw; it < 128 * I20; it += NGW) { const int mtx = it / I20; tr_item8<true>(p.in[23] + (size_t)mtx * D * 2 * DFF, 2 * DFF, P_WGU8(p) + (size_t)mtx * 2 * DFF * D, 32.f, it % I20, t, lane); }
    for (int it = gw; it < 128 * I10; it += NGW) { const int mtx = it / I10; tr_item8<false>(p.in[25] + (size_t)mtx * DFF * D, D, P_WDN8(p) + (size_t)mtx * D * DFF, 64.f, it % I10, t, lane); }
    __syncthreads();
}

namespace pg8 {
constexpr int BM = 256, BK = 64, HALF = 128, HTB = HALF * BK * 2, STAGE_BYTES = 8 * HTB, NXCD = 8, WGM = 8, K = 1024, NT = K / BK;
__host__ __device__ __forceinline__ int lds_byte(int r, int c) { const int st = (r >> 4) * 2 + (c >> 5), rr = r & 15, cc = c & 31, ob = rr * 64 + cc * 2; return st * 1024 + (ob ^ (((ob >> 9) & 1) << 5)); }
__host__ __device__ __forceinline__ void stage_rc(int b, int& R, int& C) { const int st = b / 1024, sb = b % 1024, swz = sb ^ (((sb >> 9) & 1) << 5); R = (st >> 1) * 16 + swz / 64; C = (st & 1) * 32 + (swz % 64) / 2; }
__host__ __device__ __forceinline__ int perm32(int rho) { const int n = rho >> 4, i = rho & 15; return 8 * (i >> 2) + 4 * n + (i & 3); }
struct Unit { int pm, pn, e; };
__device__ __forceinline__ bool static_next(int nM, int nN, int G, int c, int i, int& pm, int& pn, int WGM = pg8::WGM) {
    const int nwg = nM * nN; const long L = (long)i * G + c; if (L >= nwg) return false;
    int wgid = (int)L; { const int q = nwg / NXCD, r = nwg % NXCD, xcd = wgid % NXCD, off = wgid / NXCD; wgid = (xcd < r ? xcd * (q + 1) : r * (q + 1) + (xcd - r) * q) + off; }
    const int nig = WGM * nN, gid = wgid / nig, fm = gid * WGM, gsz = (nM - fm) < WGM ? (nM - fm) : WGM;
    pm = fm + ((wgid % nig) % gsz); pn = (wgid % nig) / gsz; return true;
}
template <class Epi, class Sched, bool GATHER>
__device__ __forceinline__ void gemm_phase(LAS unsigned char* lds, const Sched& S, const Epi& E) {
    const int tid = tidx(), wid = __builtin_amdgcn_readfirstlane(tid >> 6), lane = tid & 63, wr = wid >> 2, wc = wid & 3, fr = lane & 15, fq = lane >> 4;
    unsigned voffB[2], vA0[2], vA1[2], nvA0[2], nvA1[2]; int RA[2], CA[2];
    constexpr unsigned hstep = (unsigned)HALF * K * 2, kstep = BK * 2;
#pragma unroll
    for (int i = 0; i < 2; ++i) { int R, C; stage_rc(tid * 16 + i * 8192, R, C); const int Rb = (R & ~31) + perm32(R & 31);
        RA[i] = R; CA[i] = C * 2; vA0[i] = (unsigned)(R * K + C) * 2u; vA1[i] = vA0[i] + hstep; voffB[i] = (unsigned)(Rb * K + C) * 2u; }
    const unsigned ldsw = (unsigned)wid * 1024u;
    const int aoff = lds_byte(wr * 64 + fr, fq * 8), boff = lds_byte(wc * 32 + fr, fq * 8);
#define PG8_SA(b, h) (((b) * 2 + (h)) * HTB)
#define PG8_SB(b, h) ((4 + (b) * 2 + (h)) * HTB)
#define PG8_STAGE(bufoff, gbase, voff) do { _Pragma("unroll") for (int _i = 0; _i < 2; ++_i) \
        __builtin_amdgcn_global_load_lds((const unsigned*)((const char*)(gbase) + (voff)[_i]), (LAS unsigned*)(lds + (bufoff) + ldsw + _i * 8192), 16, 0, 0); } while (0)
#define PG8_LDA(dst, b, h) do { _Pragma("unroll") for (int m = 0; m < 4; ++m) _Pragma("unroll") for (int k = 0; k < 2; ++k) dst[m][k] = *(const LAS bf16x8*)(lds + PG8_SA(b, h) + aoff + m * 2048 + k * 1024); } while (0)
#define PG8_LDB(dst, b, h) do { _Pragma("unroll") for (int n = 0; n < 2; ++n) _Pragma("unroll") for (int k = 0; k < 2; ++k) dst[n][k] = *(const LAS bf16x8*)(lds + PG8_SB(b, h) + boff + n * 2048 + k * 1024); } while (0)
#define PG8_MMA(ai, bj, At, Bt) do { __builtin_amdgcn_s_setprio(1); _Pragma("unroll") for (int m = 0; m < 4; ++m) _Pragma("unroll") for (int n = 0; n < 2; ++n) _Pragma("unroll") for (int k = 0; k < 2; ++k) \
        acc[ai][bj][m][n] = __builtin_amdgcn_mfma_f32_16x16x32_bf16(Bt[n][k], At[m][k], acc[ai][bj][m][n], 0, 0, 0); __builtin_amdgcn_s_setprio(0); } while (0)
#define PG8_WAIT_V(n) asm volatile("s_waitcnt vmcnt(" #n ")" ::: "memory")
#define PG8_WAIT_L(n) asm volatile("s_waitcnt lgkmcnt(" #n ")" ::: "memory")
#define PG8_BAR __builtin_amdgcn_s_barrier()
#define PG8_SCHED __builtin_amdgcn_sched_barrier(0)
    Unit cur, nxt; int ui = 0;
    if (!S.next(0, cur)) return;
    f32x4 acc[2][2][4][2];
#pragma unroll
    for (int a = 0; a < 2; ++a)
#pragma unroll
        for (int b = 0; b < 2; ++b)
#pragma unroll
            for (int m = 0; m < 4; ++m)
#pragma unroll
                for (int n = 0; n < 2; ++n) acc[a][b][m][n] = (f32x4){0.f, 0.f, 0.f, 0.f};
    bf16x8 At[4][2], B0[2][2], B1[2][2];
    const char* cA = S.a_ptr(cur); const char* cB = S.b_ptr(cur);
    if constexpr (GATHER) { S.voff(0, RA, CA, vA0, vA1); }
    PG8_STAGE(PG8_SB(0, 0), cB, voffB); PG8_STAGE(PG8_SB(0, 1), cB + hstep, voffB); PG8_STAGE(PG8_SA(0, 0), cA, vA0); PG8_STAGE(PG8_SA(0, 1), cA, vA1);
    if (wr == 1) PG8_BAR;
    PG8_WAIT_V(2); PG8_BAR;
    PG8_STAGE(PG8_SB(1, 0), cB + kstep, voffB); PG8_STAGE(PG8_SA(1, 0), cA + kstep, vA0); PG8_STAGE(PG8_SB(1, 1), cB + hstep + kstep, voffB);
    PG8_WAIT_V(6); PG8_BAR;
    for (;;) {
        const bool has_next = S.next(ui + 1, nxt);
        const char* nA = has_next ? S.a_ptr(nxt) : cA; const char* nB = has_next ? S.b_ptr(nxt) : cB;
#pragma unroll
        for (int i = 0; i < 2; ++i) { nvA0[i] = vA0[i]; nvA1[i] = vA1[i]; }
        if constexpr (GATHER) { if (has_next) S.voff(ui + 1, RA, CA, nvA0, nvA1); }
#pragma unroll 1
        for (int t = 0; t < NT; t += 2) {
            const bool last = (t == NT - 2);
            const char* a1 = cA + (size_t)(t + 1) * kstep;
            const char* a2 = last ? nA : cA + (size_t)(t + 2) * kstep; const char* b2 = last ? nB : cB + (size_t)(t + 2) * kstep;
            const char* a3 = a2 + kstep; const char* b3 = b2 + kstep;
            unsigned w0[2], w1[2];
#pragma unroll
            for (int i = 0; i < 2; ++i) { w0[i] = (GATHER && last) ? nvA0[i] : vA0[i]; w1[i] = (GATHER && last) ? nvA1[i] : vA1[i]; }
            PG8_LDB(B0, 0, 0); PG8_LDB(B1, 0, 1); PG8_SCHED; PG8_LDA(At, 0, 0); PG8_STAGE(PG8_SA(1, 1), a1, vA1);
            PG8_WAIT_V(8); PG8_WAIT_L(0); PG8_BAR; PG8_MMA(0, 0, At, B0); PG8_MMA(0, 1, At, B1); PG8_BAR; PG8_SCHED;
            PG8_LDA(At, 0, 1); PG8_STAGE(PG8_SB(0, 0), b2, voffB); PG8_STAGE(PG8_SB(0, 1), b2 + hstep, voffB); PG8_STAGE(PG8_SA(0, 0), a2, w0);
            PG8_WAIT_V(8); PG8_WAIT_L(0); PG8_BAR; PG8_MMA(1, 0, At, B0); PG8_MMA(1, 1, At, B1); PG8_BAR; PG8_SCHED;
            PG8_LDB(B0, 1, 0); PG8_LDB(B1, 1, 1); PG8_SCHED; PG8_LDA(At, 1, 0); PG8_STAGE(PG8_SA(0, 1), a2, w1);
            PG8_WAIT_V(8); PG8_WAIT_L(0); PG8_BAR; PG8_MMA(0, 0, At, B0); PG8_MMA(0, 1, At, B1); PG8_BAR; PG8_SCHED;
            PG8_LDA(At, 1, 1); PG8_STAGE(PG8_SB(1, 0), b3, voffB); PG8_STAGE(PG8_SB(1, 1), b3 + hstep, voffB); PG8_STAGE(PG8_SA(1, 0), a3, w0);
            PG8_WAIT_V(8); PG8_WAIT_L(0); PG8_BAR; PG8_MMA(1, 0, At, B0); PG8_MMA(1, 1, At, B1); PG8_BAR; PG8_SCHED;
        }
        if (wr == 0) PG8_BAR;
        E(acc, cur, ui, wr, wc, fr, fq);
        if (!has_next) break;
#pragma unroll
        for (int a = 0; a < 2; ++a)
#pragma unroll
            for (int b = 0; b < 2; ++b)
#pragma unroll
                for (int m = 0; m < 4; ++m)
#pragma unroll
                    for (int n = 0; n < 2; ++n) acc[a][b][m][n] = (f32x4){0.f, 0.f, 0.f, 0.f};
        cur = nxt; cA = nA; cB = nB; ++ui;
#pragma unroll
        for (int i = 0; i < 2; ++i) { vA0[i] = nvA0[i]; vA1[i] = nvA1[i]; }
        if (wr == 1) PG8_BAR;
    }
    PG8_WAIT_V(0);
    PG8_BAR;
#undef PG8_SA
#undef PG8_SB
#undef PG8_STAGE
#undef PG8_LDA
#undef PG8_LDB
#undef PG8_MMA
#undef PG8_WAIT_V
#undef PG8_WAIT_L
#undef PG8_BAR
#undef PG8_SCHED
}
typedef int v8i __attribute__((ext_vector_type(8)));
template <class Epi, class Sched, bool GATHER>
__device__ __forceinline__ void gemm_phase8(LAS unsigned char* lds, const Sched& S, const Epi& E) {
    const int tid = tidx(), wid = __builtin_amdgcn_readfirstlane(tid >> 6), lane = tid & 63, wr = wid >> 2, wc = wid & 3, fr = lane & 15, fq = lane >> 4;
    unsigned voffB[2], vA0[2], vA1[2], nvA0[2], nvA1[2]; int RA[2], CA[2];
    constexpr int ROWB = 1024, NT8 = ROWB / 128;
    constexpr unsigned hstep = (unsigned)HALF * ROWB, kstep = 128;
#pragma unroll
    for (int i = 0; i < 2; ++i) { int R, C; stage_rc(tid * 16 + i * 8192, R, C); const int Rb = (R & ~31) + perm32(R & 31);
        RA[i] = R; CA[i] = C * 2; vA0[i] = (unsigned)(R * ROWB + C * 2); vA1[i] = vA0[i] + hstep; voffB[i] = (unsigned)(Rb * ROWB + C * 2); }
    const unsigned ldsw = (unsigned)wid * 1024u;
    const int aoff = lds_byte(wr * 64 + fr, fq * 8), boff = lds_byte(wc * 32 + fr, fq * 8);
#define PG8_SA(b, h) (((b) * 2 + (h)) * HTB)
#define PG8_SB(b, h) ((4 + (b) * 2 + (h)) * HTB)
#define PG8_STAGE(bufoff, gbase, voff) do { _Pragma("unroll") for (int _i = 0; _i < 2; ++_i) \
        __builtin_amdgcn_global_load_lds((const unsigned*)((const char*)(gbase) + (voff)[_i]), (LAS unsigned*)(lds + (bufoff) + ldsw + _i * 8192), 16, 0, 0); } while (0)
#define PG8_LDA(dst, b, h) do { _Pragma("unroll") for (int m = 0; m < 4; ++m) { const u32x4 lo_ = *(const LAS u32x4*)(lds + PG8_SA(b, h) + aoff + m * 2048), hi_ = *(const LAS u32x4*)(lds + PG8_SA(b, h) + aoff + m * 2048 + 1024); dst[m] = (v8i){(int)lo_.x, (int)lo_.y, (int)lo_.z, (int)lo_.w, (int)hi_.x, (int)hi_.y, (int)hi_.z, (int)hi_.w}; } } while (0)
#define PG8_LDB(dst, b, h) do { _Pragma("unroll") for (int n = 0; n < 2; ++n) { const u32x4 lo_ = *(const LAS u32x4*)(lds + PG8_SB(b, h) + boff + n * 2048), hi_ = *(const LAS u32x4*)(lds + PG8_SB(b, h) + boff + n * 2048 + 1024); dst[n] = (v8i){(int)lo_.x, (int)lo_.y, (int)lo_.z, (int)lo_.w, (int)hi_.x, (int)hi_.y, (int)hi_.z, (int)hi_.w}; } } while (0)
#define PG8_MMA(ai, bj, At, Bt) do { __builtin_amdgcn_s_setprio(1); _Pragma("unroll") for (int m = 0; m < 4; ++m) _Pragma("unroll") for (int n = 0; n < 2; ++n) \
        asm volatile("v_mfma_f32_16x16x128_f8f6f4 %0, %1, %2, %0" : "+v"(acc[ai][bj][m][n]) : "v"(Bt[n]), "v"(At[m])); __builtin_amdgcn_s_setprio(0); } while (0)
#define PG8_MMAZ(ai, bj, At, Bt) do { __builtin_amdgcn_s_setprio(1); _Pragma("unroll") for (int m = 0; m < 4; ++m) _Pragma("unroll") for (int n = 0; n < 2; ++n) \
        asm volatile("v_mfma_f32_16x16x128_f8f6f4 %0, %1, %2, 0" : "=&v"(acc[ai][bj][m][n]) : "v"(Bt[n]), "v"(At[m])); __builtin_amdgcn_s_setprio(0); } while (0)
#define PG8_WAIT_V(n) asm volatile("s_waitcnt vmcnt(" #n ")" ::: "memory")
#define PG8_WAIT_L(n) asm volatile("s_waitcnt lgkmcnt(" #n ")" ::: "memory")
#define PG8_BAR __builtin_amdgcn_s_barrier()
#define PG8_SCHED __builtin_amdgcn_sched_barrier(0)
    Unit cur, nxt; int ui = 0;
    if (!S.next(0, cur)) return;
    f32x4 acc[2][2][4][2];
    v8i At[4], B0[2], B1[2];
    const char* cA = S.a_ptr(cur); const char* cB = S.b_ptr(cur);
    if constexpr (GATHER) { S.voff(0, RA, CA, vA0, vA1); }
    PG8_STAGE(PG8_SB(0, 0), cB, voffB); PG8_STAGE(PG8_SB(0, 1), cB + hstep, voffB); PG8_STAGE(PG8_SA(0, 0), cA, vA0); PG8_STAGE(PG8_SA(0, 1), cA, vA1);
    if (wr == 1) PG8_BAR;
    PG8_WAIT_V(2); PG8_BAR;
    PG8_STAGE(PG8_SB(1, 0), cB + kstep, voffB); PG8_STAGE(PG8_SA(1, 0), cA + kstep, vA0); PG8_STAGE(PG8_SB(1, 1), cB + hstep + kstep, voffB);
    PG8_WAIT_V(6); PG8_BAR;
    for (;;) {
        const bool has_next = S.next(ui + 1, nxt);
        const char* nA = has_next ? S.a_ptr(nxt) : cA; const char* nB = has_next ? S.b_ptr(nxt) : cB;
#pragma unroll
        for (int i = 0; i < 2; ++i) { nvA0[i] = vA0[i]; nvA1[i] = vA1[i]; }
        if constexpr (GATHER) { if (has_next) S.voff(ui + 1, RA, CA, nvA0, nvA1); }
#define PG8_KBODY(MZ) { \
            const bool last = (t == NT8 - 2); \
            const char* a1 = cA + (size_t)(t + 1) * kstep; \
            const char* a2 = last ? nA : cA + (size_t)(t + 2) * kstep; const char* b2 = last ? nB : cB + (size_t)(t + 2) * kstep; \
            const char* a3 = a2 + kstep; const char* b3 = b2 + kstep; \
            unsigned w0[2], w1[2]; \
            _Pragma("unroll") \
            for (int i = 0; i < 2; ++i) { w0[i] = (GATHER && last) ? nvA0[i] : vA0[i]; w1[i] = (GATHER && last) ? nvA1[i] : vA1[i]; } \
            PG8_LDB(B0, 0, 0); PG8_LDB(B1, 0, 1); PG8_SCHED; PG8_LDA(At, 0, 0); PG8_STAGE(PG8_SA(1, 1), a1, vA1); \
            PG8_WAIT_V(8); PG8_WAIT_L(0); PG8_BAR; MZ(0, 0, At, B0); MZ(0, 1, At, B1); PG8_BAR; PG8_SCHED; \
            PG8_LDA(At, 0, 1); PG8_STAGE(PG8_SB(0, 0), b2, voffB); PG8_STAGE(PG8_SB(0, 1), b2 + hstep, voffB); PG8_STAGE(PG8_SA(0, 0), a2, w0); \
            PG8_WAIT_V(8); PG8_WAIT_L(0); PG8_BAR; MZ(1, 0, At, B0); MZ(1, 1, At, B1); PG8_BAR; PG8_SCHED; \
            PG8_LDB(B0, 1, 0); PG8_LDB(B1, 1, 1); PG8_SCHED; PG8_LDA(At, 1, 0); PG8_STAGE(PG8_SA(0, 1), a2, w1); \
            PG8_WAIT_V(8); PG8_WAIT_L(0); PG8_BAR; PG8_MMA(0, 0, At, B0); PG8_MMA(0, 1, At, B1); PG8_BAR; PG8_SCHED; \
            PG8_LDA(At, 1, 1); PG8_STAGE(PG8_SB(1, 0), b3, voffB); PG8_STAGE(PG8_SB(1, 1), b3 + hstep, voffB); PG8_STAGE(PG8_SA(1, 0), a3, w0); \
            PG8_WAIT_V(8); PG8_WAIT_L(0); PG8_BAR; PG8_MMA(1, 0, At, B0); PG8_MMA(1, 1, At, B1); PG8_BAR; PG8_SCHED; \
        }
        { constexpr int t = 0; PG8_KBODY(PG8_MMAZ) }
#pragma unroll 1
        for (int t = 2; t < NT8; t += 2) PG8_KBODY(PG8_MMA)
#undef PG8_KBODY
        if (wr == 0) PG8_BAR;
        asm volatile("s_nop 15\n\ts_nop 15" ::: "memory");
        E(acc, cur, ui, wr, wc, fr, fq);
        if (!has_next) break;
        cur = nxt; cA = nA; cB = nB; ++ui;
#pragma unroll
        for (int i = 0; i < 2; ++i) { vA0[i] = nvA0[i]; vA1[i] = nvA1[i]; }
        if (wr == 1) PG8_BAR;
    }
    PG8_WAIT_V(0);
    PG8_BAR;
#undef PG8_SA
#undef PG8_SB
#undef PG8_STAGE
#undef PG8_LDA
#undef PG8_LDB
#undef PG8_MMA
#undef PG8_MMAZ
#undef PG8_WAIT_V
#undef PG8_WAIT_L
#undef PG8_BAR
#undef PG8_SCHED
}
struct DenseSched {
    const bf16* A; const bf16* Bt; int nM, nN, G, c; const LAS int* ul;
    __device__ __forceinline__ bool next(int i, Unit& u) const { if (i >= 18) return false; const int v = __builtin_amdgcn_readfirstlane(ul[i * 4]); if (v < 0) return false;
        u.e = 0; u.pm = __builtin_amdgcn_readfirstlane(ul[i * 4 + 1]); u.pn = __builtin_amdgcn_readfirstlane(ul[i * 4 + 2]); return true; }
    __device__ __forceinline__ const char* a_ptr(const Unit& u) const { return (const char*)A + (size_t)u.pm * (2u * HALF * K * 2); }
    __device__ __forceinline__ const char* b_ptr(const Unit& u) const { return (const char*)Bt + (size_t)u.pn * (2u * HALF * K * 2); }
    __device__ __forceinline__ void voff(int, const int (&)[2], const int (&)[2], unsigned (&)[2], unsigned (&)[2]) const {}
};
__device__ __forceinline__ u32x4 pair16(const u32x2 wa, const u32x2 wb) {
    const auto rx = __builtin_amdgcn_permlane16_swap(wa.x, wb.x, false, false); const auto ry = __builtin_amdgcn_permlane16_swap(wa.y, wb.y, false, false);
    u32x4 o; o.x = rx[0]; o.y = ry[0]; o.z = rx[1]; o.w = ry[1]; return o; }
struct EpiStore {
    bf16* O; int ldc; const LAS float* biasT; float scale;
    __device__ __forceinline__ void operator()(const f32x4 (&acc)[2][2][4][2], const Unit& u, int ui, int wr, int wc, int fr, int fq) const {
        const int row0 = u.pm * BM + wr * 64 + fr, col0 = u.pn * BM + wc * 32 + 8 * fq;
        f32x4 bv[2][2];
#pragma unroll
        for (int bj = 0; bj < 2; ++bj)
#pragma unroll
            for (int n = 0; n < 2; ++n) bv[bj][n] = *(const LAS f32x4*)(biasT + ui * 256 + bj * HALF + wc * 32 + 8 * fq + 4 * n);
#pragma unroll
        for (int ai = 0; ai < 2; ++ai)
#pragma unroll
            for (int m = 0; m < 4; ++m) { bf16* rowp = O + (size_t)(row0 + ai * HALF + m * 16) * ldc + col0;
#pragma unroll
                for (int bj = 0; bj < 2; ++bj) { const f32x4 v0 = acc[ai][bj][m][0] * scale + bv[bj][0], v1 = acc[ai][bj][m][1] * scale + bv[bj][1];
                    u32x4 w; w.x = pk2(v0[0], v0[1]); w.y = pk2(v0[2], v0[3]); w.z = pk2(v1[0], v1[1]); w.w = pk2(v1[2], v1[3]);
                    *(u32x4*)(rowp + bj * HALF) = w; } }
    }
};
struct EpiStoreRopeK {
    bf16* O; int ldc; const LAS float* biasT; const LAS f32x2* ropeT; float scale;
    __device__ __forceinline__ void operator()(const f32x4 (&acc)[2][2][4][2], const Unit& u, int ui, int wr, int wc, int fr, int fq) const {
        const int row0 = u.pm * BM + wr * 64 + fr, col0 = u.pn * BM + wc * 32 + 8 * fq; const bool rk = u.pn == 4 && u.pm < ML / BM;
        const int axis = wc & 1, f0 = 8 * (fq & 1); const float sg = (fq >> 1) ? 1.f : -1.f; const int l32_ = lane_op();
        f32x4 bv[2][2];
#pragma unroll
        for (int bj = 0; bj < 2; ++bj)
#pragma unroll
            for (int n = 0; n < 2; ++n) bv[bj][n] = *(const LAS f32x4*)(biasT + ui * 256 + bj * HALF + wc * 32 + 8 * fq + 4 * n);
#pragma unroll
        for (int ai = 0; ai < 2; ++ai)
#pragma unroll
            for (int m = 0; m < 4; ++m) { const int row = row0 + ai * HALF + m * 16; bf16* rowp = O + (size_t)row * ldc + col0;
                f32x4 cs[4];
                if (rk) { const int t = row & 4095, pos = axis ? (t & 63) : (t >> 6); const LAS f32x4* cp = (const LAS f32x4*)(ropeT + pos * 16 + f0);
#pragma unroll
                    for (int q = 0; q < 4; ++q) cs[q] = cp[q]; }
#pragma unroll
                for (int bj = 0; bj < 2; ++bj) { f32x4 v0 = acc[ai][bj][m][0] * scale + bv[bj][0], v1 = acc[ai][bj][m][1] * scale + bv[bj][1];
                    if (rk) {
#pragma unroll
                        for (int j = 0; j < 4; ++j) { const float p0 = shx(v0[j], 32, l32_), p1 = shx(v1[j], 32, l32_);
                            const float c0 = (j & 1) ? cs[j >> 1].z : cs[j >> 1].x, s0 = (j & 1) ? cs[j >> 1].w : cs[j >> 1].y, c1 = (j & 1) ? cs[2 + (j >> 1)].z : cs[2 + (j >> 1)].x, s1 = (j & 1) ? cs[2 + (j >> 1)].w : cs[2 + (j >> 1)].y;
                            v0[j] = v0[j] * c0 + sg * p0 * s0; v1[j] = v1[j] * c1 + sg * p1 * s1; } }
                    u32x4 w; w.x = pk2(v0[0], v0[1]); w.y = pk2(v0[2], v0[3]); w.z = pk2(v1[0], v1[1]); w.w = pk2(v1[2], v1[3]);
                    *(u32x4*)(rowp + bj * HALF) = w; } }
    }
};
struct EpiStore8 {
    unsigned char* O; int ldc; const LAS float* biasT; float scale, oscale;
    __device__ __forceinline__ void operator()(const f32x4 (&acc)[2][2][4][2], const Unit& u, int ui, int wr, int wc, int fr, int fq) const {
        const int row0 = u.pm * BM + wr * 64 + fr, col0 = u.pn * BM + wc * 32 + 8 * fq; const float so = scale * oscale;
        f32x4 bv[2][2];
#pragma unroll
        for (int bj = 0; bj < 2; ++bj)
#pragma unroll
            for (int n = 0; n < 2; ++n) bv[bj][n] = *(const LAS f32x4*)(biasT + ui * 256 + bj * HALF + wc * 32 + 8 * fq + 4 * n) * oscale;
#pragma unroll
        for (int ai = 0; ai < 2; ++ai)
#pragma unroll
            for (int mp = 0; mp < 2; ++mp) { unsigned char* rowp = O + (size_t)(row0 + ai * HALF + (2 * mp + (fq & 1)) * 16) * ldc + (col0 - 8 * (fq & 1));
#pragma unroll
                for (int bj = 0; bj < 2; ++bj) { u32x2 w[2];
#pragma unroll
                    for (int h = 0; h < 2; ++h) { const f32x4 v0 = acc[ai][bj][2 * mp + h][0] * so + bv[bj][0], v1 = acc[ai][bj][2 * mp + h][1] * so + bv[bj][1];
                        w[h].x = pk4_fp8(v0[0], v0[1], v0[2], v0[3]); w[h].y = pk4_fp8(v1[0], v1[1], v1[2], v1[3]); }
                    *(u32x4*)(rowp + bj * HALF) = pair16(w[0], w[1]); } }
    }
};
}

template <bool ROPEK, int MODE = 0> __device__ __forceinline__ void ph_gemm(const bf16* A, const bf16* Bt, const float* bias, bf16* O, int N, int nrows, LAS unsigned char* lds, const f32x2* ropeg = nullptr) {
    pg8::DenseSched S{A, Bt, nrows / 256, N / 256, (int)gridDim.x, (int)blockIdx.x, (const LAS int*)(lds + LDS_CTL + LC_UINFO)};
    LAS float* biasT = (LAS float*)(lds + LDS_CTL + LC_BIAS);
    if constexpr (MODE != 2) { const int TX = tidx(); LAS int* ui_ = (LAS int*)(lds + LDS_CTL + LC_UINFO);
      if (TX < 18) { int pm, pn; const bool ok = pg8::static_next(S.nM, S.nN, S.G, S.c, TX, pm, pn); ui_[TX * 4] = ok ? 0 : -1; ui_[TX * 4 + 1] = pm; ui_[TX * 4 + 2] = pn; }
      __syncthreads();
#pragma unroll
      for (int it = 0; it < 9; ++it) { const int j = TX + it * NTHR, i = j >> 8; if (ui_[i * 4] >= 0) biasT[j] = bias ? bias[ui_[i * 4 + 2] * 256 + (j & 255)] : 0.f; }
      if constexpr (ROPEK) { LAS f32x2* ropeT = (LAS f32x2*)(lds + LDS_CTL + LC_TOKT); for (int i = TX; i < 1024; i += NTHR) ropeT[i] = ropeg[i]; } }
    if constexpr (MODE != 1) {
    __syncthreads();
    if constexpr (ROPEK) { pg8::EpiStoreRopeK E{O, N, biasT, (LAS f32x2*)(lds + LDS_CTL + LC_TOKT), 1.f};
        pg8::gemm_phase<pg8::EpiStoreRopeK, pg8::DenseSched, false>(lds, S, E);
    } else { pg8::EpiStore E{O, N, biasT, 1.f};
        pg8::gemm_phase<pg8::EpiStore, pg8::DenseSched, false>(lds, S, E); }
    __syncthreads(); }
}

__device__ __forceinline__ void moe_tiles_init(const Ptrs& p, int layer, LAS int* cntc, LAS int* tile0) {
    const int TX = tidx();
    const unsigned* cnt = P_CTL(p) + CW_CNT + layer * 64;
    if (TX < 32) {
        const int cn = (int)__hip_atomic_load(cnt + TX, __ATOMIC_RELAXED, __HIP_MEMORY_SCOPE_AGENT), nt = (cn + TM - 1) / TM; int incl = nt;
#pragma unroll
        for (int o = 1; o < 32; o <<= 1) { const int t = __builtin_amdgcn_ds_bpermute(((TX - o) & 63) << 2, incl); if (TX >= o) incl += t; }
        cntc[TX] = cn; tile0[TX] = incl - nt; if (TX == 31) tile0[32] = incl; }
    __syncthreads();
}
__device__ __forceinline__ int moe_find(const LAS int* tile0, int t) { int e = 0;
#pragma unroll
    for (int x = 1; x < 32; ++x) e = tile0[x] <= t ? x : e;
    return e; }

namespace pg8 {
struct MoeSched {
    const char* A; const char* Bt; const LAS int* tile0; const LAS unsigned short* tokt; int nN, G, c; bool gather; int rowb; const LAS int* ul;
    __device__ __forceinline__ bool next(int i, Unit& u) const { if (i >= 18) return false; const int e = __builtin_amdgcn_readfirstlane(ul[i * 4]); if (e < 0) return false;
        u.e = e; u.pm = __builtin_amdgcn_readfirstlane(ul[i * 4 + 1]); u.pn = __builtin_amdgcn_readfirstlane(ul[i * 4 + 2]); return true; }
    __device__ __forceinline__ const char* a_ptr(const Unit& u) const { return gather ? A : A + (size_t)u.pm * (size_t)(BM * rowb); }
    __device__ __forceinline__ const char* b_ptr(const Unit& u) const { return Bt + ((size_t)u.e * nN + u.pn) * (size_t)(BM * rowb); }
    __device__ __forceinline__ void voff(int i, const int (&R)[2], const int (&C)[2], unsigned (&v0)[2], unsigned (&v1)[2]) const {
        const LAS unsigned short* tk = tokt + i * 256 + R[0];
#pragma unroll
        for (int k = 0; k < 2; ++k) { v0[k] = (unsigned)tk[64 * k] * (unsigned)rowb + (unsigned)C[0]; v1[k] = (unsigned)tk[128 + 64 * k] * (unsigned)rowb + (unsigned)C[0]; } }
};
struct EpiSwiglu {
    unsigned char* ACT; const LAS float* biasT;
    __device__ __forceinline__ void operator()(const f32x4 (&acc)[2][2][4][2], const Unit& u, int ui, int wr, int wc, int fr, int fq) const {
        const int row0 = u.pm * BM + wr * 64 + fr, ff0 = u.pn * HALF + wc * 32 + 8 * fq; const LAS float* bg = biasT + ui * 256 + wc * 32 + 8 * fq;
        f32x4 bgv[2], buv[2]; f32x2 kc, one; asm volatile("v_mov_b32 %0, 0xc01d265f\n\tv_mov_b32 %1, 0xc01d265f\n\tv_mov_b32 %2, 1.0\n\tv_mov_b32 %3, 1.0" : "=v"(kc.x), "=v"(kc.y), "=v"(one.x), "=v"(one.y));
#pragma unroll
        for (int n = 0; n < 2; ++n) { bgv[n] = *(const LAS f32x4*)(bg + 4 * n); buv[n] = *(const LAS f32x4*)(bg + HALF + 4 * n); }
#pragma unroll
        for (int ai = 0; ai < 2; ++ai)
#pragma unroll
            for (int mp = 0; mp < 2; ++mp) { u32x2 wq[2];
#pragma unroll
            for (int mh = 0; mh < 2; ++mh) { const int m = 2 * mp + mh; float a[8];
#pragma unroll
                for (int n = 0; n < 2; ++n) { const f32x4 g4 = acc[ai][0][m][n] * 0.03125f + bgv[n], u4 = acc[ai][1][m][n] * 0.03125f + buv[n];
#pragma unroll
                    for (int jp = 0; jp < 2; ++jp) {
                        const f32x2 gt = {fminf(g4[2 * jp], 7.f), fminf(g4[2 * jp + 1], 7.f)}, up1 = {fminf(fmaxf(u4[2 * jp], -6.f), 8.f), fminf(fmaxf(u4[2 * jp + 1], -6.f), 8.f)};
                        const f32x2 x = gt * kc; f32x2 e = {__builtin_amdgcn_exp2f(x.x), __builtin_amdgcn_exp2f(x.y)}; e = e + one;
                        const f32x2 r = {__builtin_amdgcn_rcpf(e.x), __builtin_amdgcn_rcpf(e.y)}, o = (up1 * gt) * r;
                        a[4 * n + 2 * jp] = o.x; a[4 * n + 2 * jp + 1] = o.y; } }
                wq[mh].x = pk4_fp8(a[0], a[1], a[2], a[3]); wq[mh].y = pk4_fp8(a[4], a[5], a[6], a[7]); }
                *(u32x4*)(ACT + (size_t)(row0 + ai * HALF + (2 * mp + (fq & 1)) * 16) * DFF + (ff0 - 8 * (fq & 1))) = pair16(wq[0], wq[1]); }
    }
};
}
__device__ __forceinline__ void ph_moe_up(const Ptrs& p, int layer, LAS unsigned char* lds) {
    const int TX = tidx();
    LAS int* cntc = (LAS int*)(lds + LDS_CTL + LC_CNT); LAS int* tile0 = (LAS int*)(lds + LDS_CTL + LC_TILE0); LAS unsigned short* tokt = (LAS unsigned short*)(lds + LDS_CTL + LC_TOKT);
    moe_tiles_init(p, layer, cntc, tile0);
    pg8::MoeSched S{(const char*)P_H8(p), (const char*)(P_WGU8(p) + (size_t)layer * NE * 2 * DFF * D), tile0, tokt, 8, (int)gridDim.x, (int)blockIdx.x, true, 1024, (const LAS int*)(lds + LDS_CTL + LC_UINFO)};
    LAS float* biasT = (LAS float*)(lds + LDS_CTL + LC_BIAS); const float* bgu = p.in[24] + (size_t)layer * NE * 2 * DFF;
    { LAS int* ui_ = (LAS int*)(lds + LDS_CTL + LC_UINFO);
      if (TX < 18) { int pm, pn; const bool ok = pg8::static_next(tile0[32], 8, S.G, S.c, TX, pm, pn, 2);     ui_[TX * 4] = ok ? moe_find(tile0, pm) : -1; ui_[TX * 4 + 1] = pm; ui_[TX * 4 + 2] = pn; }
      __syncthreads();
#pragma unroll
      for (int it = 0; it < 9; ++it) { const int j = TX + it * NTHR, i = j >> 8, sl = j & 255, e = ui_[i * 4];
          if (e >= 0) { const int pm = ui_[i * 4 + 1], pn = ui_[i * 4 + 2], idx = (pm - tile0[e]) * TM + sl;
              tokt[j] = (unsigned short)(idx < cntc[e] ? P_TOKL(p)[(size_t)e * CAP + idx] : 0);
              biasT[j] = bgu[(size_t)e * 2 * DFF + (sl >> 7) * DFF + pn * 128 + (sl & 127)] + (sl >= 128 ? 1.f : 0.f); } } }
    __syncthreads();
    pg8::EpiSwiglu E{P_ACT8(p), biasT};
    pg8::gemm_phase8<pg8::EpiSwiglu, pg8::MoeSched, true>(lds, S, E);
    __syncthreads();
}
template <int MODE> __device__ __forceinline__ void ph_moe_down(const Ptrs& p, int layer, LAS unsigned char* lds) {
    LAS int* tile0 = (LAS int*)(lds + LDS_CTL + LC_TILE0);
    pg8::MoeSched S{(const char*)P_ACT8(p), (const char*)(P_WDN8(p) + (size_t)layer * NE * DFF * D), tile0, nullptr, 4, (int)gridDim.x, (int)blockIdx.x, false, 1024, (const LAS int*)(lds + LDS_CTL + LC_UINFO)};
    LAS float* biasT = (LAS float*)(lds + LDS_CTL + LC_BIAS); const float* bd = p.in[26] + (size_t)layer * NE * D;
    if constexpr (MODE != 2) { const int TX = tidx(); LAS int* ui_ = (LAS int*)(lds + LDS_CTL + LC_UINFO);
      if (TX < 18) { int pm, pn; const bool ok = pg8::static_next(tile0[32], 4, S.G, S.c, TX, pm, pn, 16); ui_[TX * 4] = ok ? moe_find(tile0, pm) : -1; ui_[TX * 4 + 1] = pm; ui_[TX * 4 + 2] = pn; }
      __syncthreads();
#pragma unroll
      for (int it = 0; it < 9; ++it) { const int j = TX + it * NTHR, i = j >> 8, e = ui_[i * 4]; if (e >= 0) biasT[j] = bd[(size_t)e * D + ui_[i * 4 + 2] * 256 + (j & 255)]; } }
    if constexpr (MODE != 1) {
    __syncthreads();
    pg8::EpiStore8 E{P_OUTE8(p), D, biasT, 0.015625f, 4.f};
    pg8::gemm_phase8<pg8::EpiStore8, pg8::MoeSched, false>(lds, S, E);
    __syncthreads(); }
}

template <bool ROPEK, int MODE> __device__ __forceinline__ void ph_gemm8(const unsigned char* A8, const unsigned char* Bt8, const float* bias, bf16* O, int N, int nrows, LAS unsigned char* lds, float scale, const f32x2* ropeg = nullptr) {
    pg8::MoeSched S{(const char*)A8, (const char*)Bt8, nullptr, nullptr, N / 256, (int)gridDim.x, (int)blockIdx.x, false, 1024, (const LAS int*)(lds + LDS_CTL + LC_UINFO)};
    LAS float* biasT = (LAS float*)(lds + LDS_CTL + LC_BIAS);
    if constexpr (MODE != 2) { const int TX = tidx(); LAS int* ui_ = (LAS int*)(lds + LDS_CTL + LC_UINFO);
      if (TX < 18) { int pm, pn; const bool ok = pg8::static_next(nrows / 256, N / 256, S.G, S.c, TX, pm, pn); ui_[TX * 4] = ok ? 0 : -1; ui_[TX * 4 + 1] = pm; ui_[TX * 4 + 2] = pn; }
      __syncthreads();
#pragma unroll
      for (int it = 0; it < 9; ++it) { const int j = TX + it * NTHR, i = j >> 8; if (ui_[i * 4] >= 0) biasT[j] = bias ? bias[ui_[i * 4 + 2] * 256 + (j & 255)] : 0.f; }
      if constexpr (ROPEK) { LAS f32x2* ropeT = (LAS f32x2*)(lds + LDS_CTL + LC_TOKT); for (int i = TX; i < 1024; i += NTHR) ropeT[i] = ropeg[i]; } }
    if constexpr (MODE != 1) {
    __syncthreads();
    if constexpr (ROPEK) { pg8::EpiStoreRopeK E{O, N, biasT, (LAS f32x2*)(lds + LDS_CTL + LC_TOKT), scale};
        pg8::gemm_phase8<pg8::EpiStoreRopeK, pg8::MoeSched, false>(lds, S, E);
    } else { pg8::EpiStore E{O, N, biasT, scale};
        pg8::gemm_phase8<pg8::EpiStore, pg8::MoeSched, false>(lds, S, E); }
    __syncthreads(); }
}

namespace attn_body {
using bf16=__hip_bfloat16;
using bf16x8=__attribute__((ext_vector_type(8)))short;
using s16x4=__attribute__((ext_vector_type(4)))short;
using f32x16=__attribute__((ext_vector_type(16)))float;
using u32x4=__attribute__((ext_vector_type(4)))unsigned;
constexpr int D=64,DM=1024,PQ=1536,NZT=4;
constexpr int NW=8,QBLK=32,QB=QBLK*NW,KVBLK=64;
__device__ __forceinline__ int crow(int r,int hi){return (r&3)+8*(r>>2)+4*hi;}
#define SBAR() __builtin_amdgcn_sched_barrier(0)
__device__ __forceinline__ void wmask(f32x16&p0,f32x16&p1,int drel,int hi){
  const float NEG=-INFINITY; const int kb=drel+4*hi;
  #pragma unroll
  for(int r=0;r<16;++r){const int d=kb+(r&3)+8*(r>>2); if(d>128||d<-128)p0[r]=NEG; if(d+32>128||d+32<-128)p1[r]=NEG;}
}

constexpr int NSLOT=3, SLOTB=8192;
constexpr int LDS_K=0, LDS_V=NSLOT*SLOTB, LDS_WS=2*NSLOT*SLOTB, LDS_OST=LDS_WS+NW*64*4, LDS_BYTES=LDS_OST+NW*4096;
constexpr float C2=0.125f*1.4426950408889634f;
__device__ __forceinline__ void glds16(const void*sbase,unsigned voff,unsigned lds_dst){unsigned keep;
  asm volatile("s_mov_b32 %0, m0\n\ts_mov_b32 m0, %3\n\ts_nop 0\n\tglobal_load_lds_dwordx4 %1, %2\n\ts_mov_b32 m0, %0":"=&s"(keep):"v"(voff),"s"(sbase),"s"(lds_dst):"memory");}
__device__ __forceinline__ float max3f(float a,float b,float c){float r;asm("v_max3_f32 %0, %1, %2, %3":"=v"(r):"v"(a),"v"(b),"v"(c));return r;}
__device__ __forceinline__ float max2f(float a,float b){float r;asm("v_max_f32_e32 %0, %1, %2":"=v"(r):"v"(a),"v"(b));return r;}
__device__ __forceinline__ float fadd_s(float a,float b){float r;asm("v_add_f32_e32 %0, %1, %2":"=v"(r):"v"(a),"v"(b));return r;}
__device__ __forceinline__ float fsub_s(float a,float b){float r;asm("v_sub_f32_e32 %0, %1, %2":"=v"(r):"v"(a),"v"(b));return r;}
typedef float f32x2_t __attribute__((ext_vector_type(2))); typedef __bf16 bf16x2_t __attribute__((ext_vector_type(2)));
__device__ __forceinline__ unsigned cvtpk_s(float lo,float hi){f32x2_t v={lo,hi};bf16x2_t b=__builtin_convertvector(v,bf16x2_t);return __builtin_bit_cast(unsigned,b);}
#define WAIT_BAR(N) asm volatile("s_waitcnt vmcnt(" #N ") lgkmcnt(0)\n\ts_barrier":::"memory")

__device__ __forceinline__ void qkt(f32x16&p0,f32x16&p1,const char*Kslot,const bf16x8*qr,const f32x16&negm,int r32,int hi){
  const char*kb=Kslot+hi*1024+r32*16;
  #pragma unroll
  for(int d0=0;d0<4;++d0){
    const bf16x8 b0=*reinterpret_cast<const bf16x8*>(kb+d0*2048);
    const bf16x8 b1=*reinterpret_cast<const bf16x8*>(kb+d0*2048+512);
    if(d0==0){p0=__builtin_amdgcn_mfma_f32_32x32x16_bf16(b0,qr[0],negm,0,0,0);p1=__builtin_amdgcn_mfma_f32_32x32x16_bf16(b1,qr[0],negm,0,0,0);}
    else{p0=__builtin_amdgcn_mfma_f32_32x32x16_bf16(b0,qr[d0],p0,0,0,0);p1=__builtin_amdgcn_mfma_f32_32x32x16_bf16(b1,qr[d0],p1,0,0,0);}}
}
typedef __attribute__((address_space(3))) const char* lds_cptr;
typedef short v4i16_t __attribute__((ext_vector_type(4)));
__device__ __forceinline__ void kload8(bf16x8*kf,lds_cptr kp){
  kf[0]=*(const __attribute__((address_space(3))) bf16x8*)(kp);      kf[1]=*(const __attribute__((address_space(3))) bf16x8*)(kp+512);
  kf[2]=*(const __attribute__((address_space(3))) bf16x8*)(kp+2048); kf[3]=*(const __attribute__((address_space(3))) bf16x8*)(kp+2560);
  kf[4]=*(const __attribute__((address_space(3))) bf16x8*)(kp+4096); kf[5]=*(const __attribute__((address_space(3))) bf16x8*)(kp+4608);
  kf[6]=*(const __attribute__((address_space(3))) bf16x8*)(kp+6144); kf[7]=*(const __attribute__((address_space(3))) bf16x8*)(kp+6656);
}
__device__ __forceinline__ void kload2(bf16x8*kf,lds_cptr kp,int j){ kf[2*j]=*(const __attribute__((address_space(3))) bf16x8*)(kp+j*2048); kf[2*j+1]=*(const __attribute__((address_space(3))) bf16x8*)(kp+j*2048+512); }
__device__ __forceinline__ s16x4 vtr(lds_cptr p){ return __builtin_bit_cast(s16x4,__builtin_amdgcn_ds_read_tr16_b64_v4i16((__attribute__((address_space(3))) v4i16_t*)p)); }
__device__ __forceinline__ float rowmax(const f32x16&p0,const f32x16&p1){
  float a=max3f(p0[0],p0[1],p1[0]),b=max3f(p0[2],p0[3],p1[1]);a=max3f(a,p1[2],p1[3]);
  #pragma unroll
  for(int r=4;r<16;r+=4){a=max3f(a,p0[r],p0[r+1]);b=max3f(b,p0[r+2],p0[r+3]);a=max3f(a,p1[r],p1[r+1]);b=max3f(b,p1[r+2],p1[r+3]);}
  const float m=max2f(a,b);
  auto rr=__builtin_amdgcn_permlane32_swap(__float_as_uint(m),__float_as_uint(m),false,false);
  return max2f(__uint_as_float(rr[0]),__uint_as_float(rr[1]));
}
__device__ __forceinline__ void pv(f32x16*o,int vb,bf16x8 pa0,bf16x8 pa1,bf16x8 pa2,bf16x8 pa3){
  #pragma unroll
  for(int d0=0;d0<2;++d0){s16x4 lo[4],hi[4];
    #pragma unroll
    for(int ks=0;ks<4;++ks){
      asm volatile("ds_read_b64_tr_b16 %0,%1 offset:%c2":"=&v"(lo[ks]):"v"(vb),"i"(d0*4096+ks*1024):"memory");
      asm volatile("ds_read_b64_tr_b16 %0,%1 offset:%c2":"=&v"(hi[ks]):"v"(vb),"i"(d0*4096+ks*1024+512):"memory");}
    asm volatile("s_waitcnt lgkmcnt(0)":::"memory");SBAR();
    #define PK(k) (bf16x8){lo[k][0],lo[k][1],lo[k][2],lo[k][3],hi[k][0],hi[k][1],hi[k][2],hi[k][3]}
    o[d0]=__builtin_amdgcn_mfma_f32_32x32x16_bf16(pa0,PK(0),o[d0],0,0,0);
    o[d0]=__builtin_amdgcn_mfma_f32_32x32x16_bf16(pa1,PK(1),o[d0],0,0,0);
    o[d0]=__builtin_amdgcn_mfma_f32_32x32x16_bf16(pa2,PK(2),o[d0],0,0,0);
    o[d0]=__builtin_amdgcn_mfma_f32_32x32x16_bf16(pa3,PK(3),o[d0],0,0,0);
    #undef PK
  }
}

#ifndef ATTN_STORE16
#define ATTN_STORE16(p,v) (*(u32x4*)(p)=(v))
#endif
template<int THRL,bool WIN,bool PAIR> __device__ __forceinline__ void attn_unit(int qrow0,int qpos0,int h,int zrow0,int lrow0,int lpos0,int NT,const float*sinkp,const float*qn,const float*ropet,bool rope,const bf16*__restrict__ QKV,unsigned char*O8,char*shm){
  const int tid=tidx(),lane=tid&63,r32=lane&31,hi=lane>>5; const int wid=__builtin_amdgcn_readfirstlane(tid>>6);
  const int qw=PAIR?(wid&3):wid, hh=PAIR?h+(wid>>2):h;
  const float sinkl2=WIN?sinkp[hh]*1.4426950408889634f:0.f;
  const bf16*Qw=QKV+(long)(qrow0+qw*QBLK)*PQ+hh*D;
  const bf16*Kh=QKV+1024+(h>>2)*D,*Vh=QKV+1280+(h>>2)*D;
  const unsigned lds0=(unsigned)(uintptr_t)shm;
  float*wsf=(float*)(shm+LDS_WS)+wid*64;
  const unsigned koff=(unsigned)(lane*PQ+wid*8)*2u;
  const unsigned voffv=(unsigned)((16*(wid&3)+(lane>>2))*PQ+(wid>>2)*32+(lane&3)*8)*2u;
  #define TROW(t) ((t)<NZT?zrow0+KVBLK*(t):lrow0+KVBLK*((t)-NZT))
  const unsigned kdst=lds0+LDS_K+wid*1024, vdst=lds0+LDS_V+wid*1024;
  #define DMA_K(t,slot) glds16(Kh+(long)TROW(t)*PQ,koff,(unsigned)__builtin_amdgcn_readfirstlane(kdst+(slot)))
  #define DMA_V(t,slot) glds16(Vh+(long)TROW(t)*PQ,voffv,(unsigned)__builtin_amdgcn_readfirstlane(vdst+(slot)))
  const int vb0=(int)(lds0+LDS_V)+((lane>>4)&1)*32+(lane&3)*8+(4*hi+((lane&15)>>2))*64;
  const char*Kbase=shm+LDS_K; bf16x8 kf[8];
  const lds_cptr shm3=(lds_cptr)shm; const lds_cptr kp0=shm3+LDS_K+hi*1024+r32*16; const lds_cptr vp0=shm3+LDS_V+((lane>>4)&1)*32+(lane&3)*8+(4*hi+((lane&15)>>2))*64;
  DMA_K(0,0);DMA_V(0,0);DMA_K(1,SLOTB);
  bf16x8 qr[4];
  #pragma unroll
  for(int d0=0;d0<4;++d0)qr[d0]=*reinterpret_cast<const bf16x8*>(&Qw[(long)r32*PQ+d0*16+hi*8]);
  { float q[4][8];
    #pragma unroll
    for(int d0=0;d0<4;++d0){
      #pragma unroll
      for(int j=0;j<8;++j)q[d0][j]=__uint_as_float(((unsigned)(unsigned short)qr[d0][j])<<16);}
    if(!WIN){ float ss=0.f;
      #pragma unroll
      for(int d0=0;d0<4;++d0){
        #pragma unroll
        for(int j=0;j<8;++j)ss+=q[d0][j]*q[d0][j];}
      ss+=::shx(ss,32,lane); const float rs=1.0f/sqrtf(ss*(1.f/64.f)+1e-6f);
      #pragma unroll
      for(int d0=0;d0<4;++d0){ const float4 g0=*reinterpret_cast<const float4*>(qn+16*d0+8*hi),g1=*reinterpret_cast<const float4*>(qn+16*d0+8*hi+4);
        q[d0][0]*=rs*g0.x;q[d0][1]*=rs*g0.y;q[d0][2]*=rs*g0.z;q[d0][3]*=rs*g0.w;q[d0][4]*=rs*g1.x;q[d0][5]*=rs*g1.y;q[d0][6]*=rs*g1.z;q[d0][7]*=rs*g1.w;} }
    if(rope){ const int t=qpos0+qw*QBLK+r32;
      #pragma unroll
      for(int a=0;a<2;++a){ const int pos=a?(t&63):(t>>6); const float4*cp=reinterpret_cast<const float4*>(ropet+(pos*16+8*hi)*2);
        #pragma unroll
        for(int jp=0;jp<4;++jp){ const float4 c=cp[jp];
          { const float x1=q[2*a][2*jp],x2=q[2*a+1][2*jp]; q[2*a][2*jp]=x1*c.x-x2*c.y; q[2*a+1][2*jp]=x2*c.x+x1*c.y; }
          { const float x1=q[2*a][2*jp+1],x2=q[2*a+1][2*jp+1]; q[2*a][2*jp+1]=x1*c.z-x2*c.w; q[2*a+1][2*jp+1]=x2*c.z+x1*c.w; } } } }
    #pragma unroll
    for(int d0=0;d0<4;++d0){ u32x4 w; w.x=cvtpk_s(q[d0][0]*C2,q[d0][1]*C2); w.y=cvtpk_s(q[d0][2]*C2,q[d0][3]*C2); w.z=cvtpk_s(q[d0][4]*C2,q[d0][5]*C2); w.w=cvtpk_s(q[d0][6]*C2,q[d0][7]*C2); qr[d0]=__builtin_bit_cast(bf16x8,w); } }
  float mhat=0.f,l_reg=0.f;f32x16 o[2],negm; { float z_=0.f; asm volatile("":"+v"(z_));
    _Pragma("unroll") for(int r=0;r<16;++r){o[0][r]=z_;o[1][r]=z_;negm[r]=z_;} } asm volatile("":"+v"(negm));
  const int qrel=wid*QBLK+r32;
  #define CMASK(P0,P1,t) do{ if(WIN&&(t)>=NZT){ const int dw_=lpos0+KVBLK*((t)-NZT)-(qpos0+qw*QBLK);     \
      if(dw_>159||dw_<-191){ float ni_=-INFINITY; asm volatile("":"+v"(ni_)); _Pragma("unroll") for(int r=0;r<16;++r){P0[r]=ni_;P1[r]=ni_;} }     \
      else if(dw_>64||dw_<-96){ int lm_=lane; asm volatile("":"+v"(lm_)); wmask(P0,P1,dw_-(lm_&31),lm_>>5); } } }while(0)
  bool resc=false;
  #define START(P0,P1) do{ const float rm=rowmax(P0,P1); resc=false; \
    { const float dl=rm; mhat=fadd_s(mhat,dl); \
      _Pragma("unroll") for(int r=0;r<16;++r){P0[r]=fsub_s(P0[r],dl);P1[r]=fsub_s(P1[r],dl);} \
      _Pragma("unroll") for(int r=0;r<16;++r)negm[r]=-mhat; asm volatile("":"+v"(negm)); } \
    _Pragma("unroll") for(int r=0;r<16;++r)P0[r]=__builtin_amdgcn_exp2f(P0[r]); }while(0)
  #define RESC() do{ if(resc){ asm volatile("s_waitcnt lgkmcnt(0)":::"memory"); \
      _Pragma("unroll") for(int d_=0;d_<2;++d_) _Pragma("unroll") for(int r=0;r<16;++r)o[d_][r]*=wsf[crow(r,hi)]; } }while(0)
  f32x16 pA0,pA1,pB0,pB1;
  int sl_prev=0,sl_cur=0,sl_next=SLOTB;
  #define ROT() do{sl_prev=sl_cur;sl_cur=sl_next;sl_next=(sl_next==(NSLOT-1)*SLOTB)?0:sl_next+SLOTB;}while(0)
  DMA_K(2,2*SLOTB);
  WAIT_BAR(3);
  qkt(pA0,pA1,Kbase,qr,negm,r32,hi);asm volatile("s_nop 15\n\ts_nop 7":"+v"(pA0),"+v"(pA1));CMASK(pA0,pA1,0);
  START(pA0,pA1);
  _Pragma("unroll") for(int r=0;r<16;++r)pA1[r]=__builtin_amdgcn_exp2f(pA1[r]);
  WAIT_BAR(0);
  DMA_K(3,0);DMA_V(1,SLOTB);
  ROT();
  kload8(kf,kp0+sl_cur);
  WAIT_BAR(2);
  s16x4 vlo[8],vhi[8]; u32x4 pw0,pw1,pw2,pw3;
  #define PKW(P,B) cvtpk_s(P[B],P[B+1])
  #define PAF(k) __builtin_bit_cast(bf16x8,pw##k)
  #define VFR(i) (bf16x8){vlo[i][0],vlo[i][1],vlo[i][2],vlo[i][3],vhi[i][0],vhi[i][1],vhi[i][2],vhi[i][3]}
  #define PIN(x) asm volatile("":"+v"(x))
  #define MX3(a,b,c) __builtin_fmaxf(__builtin_fmaxf((a),(b)),(c))
  #define GAPA(MF,A0,A1,A2,A3,W0,W1,PW) do{ MF; sacc+=A0; sacc+=A1; sacc+=A2; sacc+=A3; PIN(sacc); W0; W1; PIN(PW); SBAR(); }while(0)
  #define EX(v) __builtin_amdgcn_exp2f(v)
  #define GAPB(MF,X,B) do{ MF; X[B]=EX(X[B]); X[B+1]=EX(X[B+1]); X[B+2]=EX(X[B+2]); X[B+3]=EX(X[B+3]); PIN(X); SBAR(); }while(0)
  #define VRD(i) do{ vlo[i]=vtr(vp_+(((i)>>2)*4096+((i)&3)*1024)); vhi[i]=vtr(vp_+(((i)>>2)*4096+((i)&3)*1024+512)); }while(0)
  #define KRD(G,j) do{ if(G){ kload2(kf,kp0+sl_next,j); SBAR(); } }while(0)
  #define STEP(C0,C1,P0,P1,t,GK,GV,GL) do{ SBAR(); \
    const lds_cptr vp_=vp0+sl_prev; \
    VRD(0); SBAR(); float sacc=(P0[0]+P0[1]); \
    GAPA(C0=__builtin_amdgcn_mfma_f32_32x32x16_bf16(kf[0],qr[0],negm,0,0,0), P0[2],P0[3],P0[4],P0[5],     pw0[0]=PKW(P0,0), pw0[1]=PKW(P0,2), pw0); \
    VRD(4); SBAR(); GAPA(C1=__builtin_amdgcn_mfma_f32_32x32x16_bf16(kf[1],qr[0],negm,0,0,0), P0[6],P0[7],P0[8],P0[9],     pw0[2]=PKW(P0,4), pw0[3]=PKW(P0,6), pw0); \
    VRD(1); SBAR(); GAPA(C0=__builtin_amdgcn_mfma_f32_32x32x16_bf16(kf[2],qr[1],C0,0,0,0),   P0[10],P0[11],P0[12],P0[13], pw1[0]=PKW(P0,8), pw1[1]=PKW(P0,10), pw1); \
    VRD(5); SBAR(); GAPA(C1=__builtin_amdgcn_mfma_f32_32x32x16_bf16(kf[3],qr[1],C1,0,0,0),   P0[14],P0[15],P1[0],P1[1],   pw1[2]=PKW(P0,12),pw1[3]=PKW(P0,14), pw1); \
    VRD(2); SBAR(); GAPA(C0=__builtin_amdgcn_mfma_f32_32x32x16_bf16(kf[4],qr[2],C0,0,0,0),   P1[2],P1[3],P1[4],P1[5],     pw2[0]=PKW(P1,0), pw2[1]=PKW(P1,2), pw2); \
    VRD(6); SBAR(); GAPA(C1=__builtin_amdgcn_mfma_f32_32x32x16_bf16(kf[5],qr[2],C1,0,0,0),   P1[6],P1[7],P1[8],P1[9],     pw2[2]=PKW(P1,4), pw2[3]=PKW(P1,6), pw2); \
    VRD(3); SBAR(); GAPA(C0=__builtin_amdgcn_mfma_f32_32x32x16_bf16(kf[6],qr[3],C0,0,0,0),   P1[10],P1[11],P1[12],P1[13], pw3[0]=PKW(P1,8), pw3[1]=PKW(P1,10), pw3); \
    VRD(7); SBAR(); GAPA(C1=__builtin_amdgcn_mfma_f32_32x32x16_bf16(kf[7],qr[3],C1,0,0,0),   P1[14],P1[15],0.f,0.f,       pw3[2]=PKW(P1,12),pw3[3]=PKW(P1,14), pw3); \
    l_reg+=sacc; \
    if(GK){DMA_K((t)+3,sl_cur);} if(GV){DMA_V((t)+1,sl_next);} \
    CMASK(C0,C1,t); \
    { float a=MX3(C0[0],C0[1],C1[0]),b=MX3(C0[2],C0[3],C1[1]); a=MX3(a,C1[2],C1[3]); \
      _Pragma("unroll") for(int r=4;r<16;r+=4){a=MX3(a,C0[r],C0[r+1]);b=MX3(b,C0[r+2],C0[r+3]);a=MX3(a,C1[r],C1[r+1]);b=MX3(b,C1[r+2],C1[r+3]);} \
      float rm=__builtin_fmaxf(a,b); { auto rr=__builtin_amdgcn_permlane32_swap(__float_as_uint(rm),__float_as_uint(rm),false,false); rm=__builtin_fmaxf(__uint_as_float(rr[0]),__uint_as_float(rr[1])); } \
      resc=false; \
      if(__builtin_expect(__any(rm>(float)THRL),0)){ const float dl=__builtin_fmaxf(rm,0.f); mhat+=dl; \
        _Pragma("unroll") for(int r=0;r<16;++r){C0[r]-=dl;C1[r]-=dl;} \
        _Pragma("unroll") for(int r=0;r<16;++r)negm[r]=-mhat; asm volatile("":"+v"(negm)); \
        const float f=__builtin_amdgcn_exp2f(-dl); l_reg*=f; if(hi==0)wsf[r32]=f; resc=true; } } \
    SBAR(); \
    GAPB(o[0]=__builtin_amdgcn_mfma_f32_32x32x16_bf16(PAF(0),VFR(0),o[0],0,0,0), C0,0); \
    GAPB(o[1]=__builtin_amdgcn_mfma_f32_32x32x16_bf16(PAF(0),VFR(4),o[1],0,0,0), C0,4); \
    KRD(GL,0); GAPB(o[0]=__builtin_amdgcn_mfma_f32_32x32x16_bf16(PAF(1),VFR(1),o[0],0,0,0), C0,8); \
    KRD(GL,1); GAPB(o[1]=__builtin_amdgcn_mfma_f32_32x32x16_bf16(PAF(1),VFR(5),o[1],0,0,0), C0,12); \
    KRD(GL,2); GAPB(o[0]=__builtin_amdgcn_mfma_f32_32x32x16_bf16(PAF(2),VFR(2),o[0],0,0,0), C1,0); \
    KRD(GL,3); GAPB(o[1]=__builtin_amdgcn_mfma_f32_32x32x16_bf16(PAF(2),VFR(6),o[1],0,0,0), C1,4); \
    GAPB(o[0]=__builtin_amdgcn_mfma_f32_32x32x16_bf16(PAF(3),VFR(3),o[0],0,0,0), C1,8); \
    GAPB(o[1]=__builtin_amdgcn_mfma_f32_32x32x16_bf16(PAF(3),VFR(7),o[1],0,0,0), C1,12); \
    }while(0)
  int t=1;
  for(;t+5<NT;t+=2){
    STEP(pB0,pB1,pA0,pA1,t,true,true,true);     WAIT_BAR(2); RESC(); ROT();
    STEP(pA0,pA1,pB0,pB1,t+1,true,true,true);   WAIT_BAR(2); RESC(); ROT();
  }
  #define ENDW(tt) do{ if((tt)+3<NT){WAIT_BAR(2);} else if((tt)+2<NT){WAIT_BAR(1);} else {WAIT_BAR(0);} }while(0)
  for(;t+1<NT;t+=2){
    STEP(pB0,pB1,pA0,pA1,t,(t+3<NT),(t+1<NT),(t+1<NT));       ENDW(t);   RESC(); ROT();
    STEP(pA0,pA1,pB0,pB1,t+1,(t+4<NT),(t+2<NT),(t+2<NT));     ENDW(t+1); RESC(); ROT();
  }
  STEP(pB0,pB1,pA0,pA1,NT-1,false,false,false); RESC();
  { float sacc=pB0[0]+pB0[1]; _Pragma("unroll") for(int r=2;r<16;++r)sacc+=pB0[r]; _Pragma("unroll") for(int r=0;r<16;++r)sacc+=pB1[r]; l_reg+=sacc;
    pw0=(u32x4){PKW(pB0,0),PKW(pB0,2),PKW(pB0,4),PKW(pB0,6)};pw1=(u32x4){PKW(pB0,8),PKW(pB0,10),PKW(pB0,12),PKW(pB0,14)};pw2=(u32x4){PKW(pB1,0),PKW(pB1,2),PKW(pB1,4),PKW(pB1,6)};pw3=(u32x4){PKW(pB1,8),PKW(pB1,10),PKW(pB1,12),PKW(pB1,14)};
    SBAR(); pv(o,vb0+sl_cur,PAF(0),PAF(1),PAF(2),PAF(3)); }
  #undef PKW
  #undef PAF
  #undef VFR
  #undef PIN
  #undef MX3
  #undef GAPA
  #undef GAPB
  #undef EX
  #undef VRD
  #undef KRD
  #undef STEP
  #undef ENDW
  int lane_e=lane; asm volatile("":"+v"(lane_e)); const int r32e=lane_e&31,hie=lane_e>>5;
  {auto rr=__builtin_amdgcn_permlane32_swap(__float_as_uint(l_reg),__float_as_uint(l_reg),false,false);l_reg=__uint_as_float(rr[0])+__uint_as_float(rr[1]);}
  if(WIN)l_reg+=__builtin_amdgcn_exp2f(sinkl2-mhat);
  if(hie==0)wsf[32+r32e]=l_reg;asm volatile("s_waitcnt lgkmcnt(0)":::"memory");
  float rli[16];
  #pragma unroll
  for(int r=0;r<16;++r)rli[r]=__builtin_amdgcn_rcpf(wsf[32+crow(r,hie)]);
  unsigned char*Ow=O8+(long)(qrow0+qw*QBLK)*DM+hh*D;
  { bf16*stg=(bf16*)(shm+LDS_OST)+wid*2048;
    #pragma unroll
    for(int r=0;r<16;++r){const int orow=crow(r,hie);
      #pragma unroll
      for(int d0=0;d0<2;++d0)stg[orow*64+d0*32+r32e]=__float2bfloat16(o[d0][r]*rli[r]);}
    asm volatile("s_waitcnt lgkmcnt(0)":::"memory");
    #pragma unroll
    for(int i=0;i<2;++i){const int row=i*16+(lane_e>>2),ch=lane_e&3; const u32x4 va=*(const u32x4*)(stg+row*64+ch*16),vb=*(const u32x4*)(stg+row*64+ch*16+8);
      u32x4 w8;
      #define F8LO(x) fminf(fmaxf(__uint_as_float((x)<<16)*OSC_ATT,-448.f),448.f)
      #define F8HI(x) fminf(fmaxf(__uint_as_float((x)&0xffff0000u)*OSC_ATT,-448.f),448.f)
      w8.x=::pk4_fp8(F8LO(va.x),F8HI(va.x),F8LO(va.y),F8HI(va.y)); w8.y=::pk4_fp8(F8LO(va.z),F8HI(va.z),F8LO(va.w),F8HI(va.w));
      w8.z=::pk4_fp8(F8LO(vb.x),F8HI(vb.x),F8LO(vb.y),F8HI(vb.y)); w8.w=::pk4_fp8(F8LO(vb.z),F8HI(vb.z),F8LO(vb.w),F8HI(vb.w));
      #undef F8LO
      #undef F8HI
      ATTN_STORE16(Ow+(long)row*DM+ch*16,w8);} }
  asm volatile("s_waitcnt lgkmcnt(0)\n\ts_barrier":::"memory");
  #undef TROW
  #undef DMA_K
  #undef DMA_V
  #undef CMASK
  #undef START
  #undef RESC
  #undef ROT
}
constexpr int ATTN_LDS_BYTES=LDS_BYTES;
#undef SBAR
#undef WAIT_BAR
}

template <bool WIN> __device__ __forceinline__ void ph_attn(const Ptrs& p, const float* sink, const float* qn, bool need_ctx, char* shm) {
    const int G = gridDim.x, c = blockIdx.x, per = (2048 + G - 1) / G;
    const int cs = (G & 7) == 0 ? (c & 7) * (G >> 3) + (c >> 3) : c;
    const attn_body::bf16* qkv = (const attn_body::bf16*)P_BIG(p); unsigned char* o = P_O8(p);
    for (int u = cs * per; u < (cs + 1) * per && u < 2048; ++u) {
        if constexpr (WIN) {
            const int b = u >> 8, h = ((u >> 5) & 7) * 2, qb = u & 31;
            int lt0 = 2 * qb - 2; if (lt0 < 0) lt0 = 0; int lt1 = 2 * qb + 4; if (lt1 > 64) lt1 = 64;
            attn_body::attn_unit<8, true, true>(b * SEQ + qb * 128, qb * 128, h, ML + b * CL, b * SEQ + 64 * lt0, 64 * lt0, 4 + lt1 - lt0, sink, qn, (const float*)P_ROPE(p), true, qkv, o, shm);
        } else {
            const int b = u >> 8, h = (u >> 4) & 15, qb = u & 15;
            attn_body::attn_unit<8, false, false>(b * SEQ + qb * 256, qb * 256, h, ML + b * CL, b * SEQ, 0, 4 + 64, sink, qn, (const float*)P_ROPE(p), true, qkv, o, shm); }
    }
    if (need_ctx) for (int u = c; u < 128; u += G) {
        const int b = u >> 4, h = u & 15;
        attn_body::attn_unit<8, WIN, false>(ML + b * CL, 0, h, ML + b * CL, 0, 0, 4, sink, qn, (const float*)P_ROPE(p), false, qkv, o, shm);
    }
    __syncthreads();
}

struct Args { Ptrs p; int lo, hi; };
__global__ void __launch_bounds__(NTHR, 2) mk_fwd(Args a) {
    extern __shared__ __attribute__((aligned(16))) unsigned char lds_raw[];
    LAS unsigned char* lds = (LAS unsigned char*)lds_raw;
    typedef const __attribute__((address_space(4))) Args CArgs;
    CArgs* const ka = (CArgs*)__builtin_amdgcn_kernarg_segment_ptr();
    const Ptrs& p = a.p;
    for (int u = threadIdx.x; u < (LDS_BYTES - LDS_CTL) / 4; u += NTHR) ((LAS unsigned*)(lds + LDS_CTL))[u] = 0u;
    __syncthreads();
    if ((threadIdx.x & 63) == 0) *(LAS int*)(lds + LDS_CTL + LC_WTAB + 4 * hw_slot()) = (int)(threadIdx.x >> 6);
    __syncthreads();
    XcdBarrier bar = xcd_barrier_post(P_CTL(p) + CW_BAR, (volatile LAS unsigned*)(lds + LDS_CTL + LC_BAR));
#define LOADP CArgs* kq_ = ka; asm volatile("" : "+s"(kq_)); Ptrs p; _Pragma("unroll") for (int i_ = 0; i_ < 27; ++i_) p.in[i_] = kq_->p.in[i_]; p.out = kq_->p.out; p.ws = kq_->p.ws
#define PHN(BODY, NEXTPRO) do { { LOADP; BODY; } { const XbTicket tk_ = xcd_arrive(bar); { LOADP; NEXTPRO; } xcd_wait(bar, tk_); } } while (0)
#define NOPRO (void)0
#define GEMM1(MODE, LY) do { const int k_ = (LY) % 3, j_ = (LY) / 3; const int rq_ = (LY) < DEPTH - 1 ? M : ML; \
        const bf16* W1_ = P_WT(p) + (size_t)(k_ == 0 ? WT_WINQKV + j_ * QKVD : k_ == 1 ? WT_CONVIN : WT_FULLQKV) * D; const float* b1_ = k_ == 0 ? p.in[11] + (size_t)j_ * QKVD : nullptr; \
        const int N1_ = k_ == 1 ? 3072 : QKVD, rows1_ = k_ == 1 ? rq_ : M; \
        if (k_ == 0) { if (G1F8 & 1u) (ph_gemm8<true, MODE>(P_H8A(p), P_WQ8W(p, j_), b1_, P_BIG(p), N1_, rows1_, lds, 0.03125f, P_ROPE(p))); else (ph_gemm<true, MODE>(P_H(p), W1_, b1_, P_BIG(p), N1_, rows1_, lds, P_ROPE(p))); } \
        else if (k_ == 2 && (G1F8 & 4u)) (ph_gemm8<false, MODE>(P_H8A(p), P_WQ8F(p), nullptr, P_BIG(p), N1_, rows1_, lds, 0.03125f)); \
        else (ph_gemm<false, MODE>(P_H(p), W1_, b1_, P_BIG(p), N1_, rows1_, lds)); } while (0)
#define WO(MODE) (ph_gemm8<false, MODE>(P_O8(p), P_WO8(p) + (size_t)(kind == 0 ? j : kind == 1 ? 2 : 3) * D * D, nullptr, P_MX(p), D, rq, lds, kind == 1 ? 1.f / (64.f * OSC_CONV) : 1.f / (64.f * OSC_ATT)))
    LAS int* lcnt = (LAS int*)(lds + LDS_CTL + LC_LCNT); LAS int* lbase = (LAS int*)(lds + LDS_CTL + LC_LBASE); LAS int* pst = (LAS int*)(lds + LDS_CTL + LC_PST); LAS int* lasg = (LAS int*)(lds + LDS_CTL + LC_LASG);
    PHN(ph_weights(p, lds); ph_mod(p, lds), NOPRO);
    PHN(ph_input(p), GEMM1(1, 0));
    for (int layer = 0; layer < DEPTH; ++layer) {
        const int kind = layer % 3, j = layer / 3; const bool need_ctx = layer < DEPTH - 1; const int rq = need_ctx ? M : ML;
        PHN(GEMM1(2, layer), NOPRO);
        if (kind != 0) PHN(if (kind == 1) ph_conv(p, p.in[15] + (size_t)j * 3 * D, rq); else ph_kproc<2>(p, p.in[19] + j * 64), if (kind == 1) WO(1));
        if (kind != 1) PHN(if (kind == 0) ph_attn<true>(p, p.in[12] + j * 16, nullptr, need_ctx, (char*)lds_raw); else ph_attn<false>(p, nullptr, p.in[18] + j * 64, need_ctx, (char*)lds_raw), WO(1));
        { bf16x8 wh[4][2], wl[4][2];
          PHN(WO(2), ph_ln1_pro(p, layer, lcnt, wh, wl));
          PHN(ph_ln1(p, layer, rq, lcnt, lbase, lasg, lds, wh, wl), NOPRO); }
        PHN(ph_moe_up(p, layer, lds), (ph_moe_down<1>(p, layer, lds)));
        PHN((ph_moe_down<2>(p, layer, lds)), NOPRO);
        { LOADP; ph_ln2(p, layer, rq, pst, (const LAS int*)(lds + LDS_CTL + LC_TILE0), kind == 0 ? (G1F8 & 2u) != 0u : kind == 1 ? (G1F8 & 4u) != 0u : (G1F8 & 1u) != 0u); }
        if (layer + 1 < DEPTH) { const XbTicket tk_ = xcd_arrive(bar); { LOADP; GEMM1(1, layer + 1); } xcd_wait(bar, tk_); }
    }
#undef PHN
#undef GEMM1
#undef WO
#undef LOADP
#undef NOPRO
}

extern "C" void kernel_launch(void* const* d_in, const int* in_sizes, int n_in, void* d_out, int out_size, void* d_ws, size_t ws_size, hipStream_t stream) {
    static int grid = 0;
    if (grid == 0) {
        if (n_in != 27 || out_size != ML * D || ws_size < WS_END) { fprintf(stderr, "kernel_launch: unexpected shapes (n_in %d out %d ws %zu need %zu)\n", n_in, out_size, ws_size, (size_t)WS_END); grid = -1; return; }
        int dev = 0, cus = 0, per_cu = 0;
        if (hipGetDevice(&dev) != hipSuccess || hipDeviceGetAttribute(&cus, hipDeviceAttributeMultiprocessorCount, dev) != hipSuccess) { grid = -1; return; }
        if (hipFuncSetAttribute((const void*)mk_fwd, hipFuncAttributeMaxDynamicSharedMemorySize, LDS_BYTES) != hipSuccess) { fprintf(stderr, "kernel_launch: hipFuncSetAttribute failed\n"); grid = -1; return; }
        if (hipOccupancyMaxActiveBlocksPerMultiprocessor(&per_cu, (const void*)mk_fwd, NTHR, LDS_BYTES) != hipSuccess || per_cu < 1) fprintf(stderr, "kernel_launch: occupancy query says %d\n", per_cu);
        (void)hipGetLastError();
        grid = cus;
    }
    if (grid < 0) return;
    (void)hipMemsetAsync((char*)d_ws + WS_CTL, 0, CTL_BYTES, stream);
    Args a{};
    for (int i = 0; i < 27; ++i) a.p.in[i] = (const float*)d_in[i];
    a.p.out = (float*)d_out; a.p.ws = (unsigned char*)d_ws; a.lo = 0; a.hi = 1000;
    hipLaunchKernelGGL(mk_fwd, dim3(grid), dim3(NTHR), LDS_BYTES, stream, a);
}
```
